# Optimizing an MI355X kernel written in HIP

```python
import math
import jax, jax.numpy as jnp
from jax import lax
import numpy as np

D_MODEL = 1024
BATCH = 16
SEQ = 2048
DEPTH = 2
DEC_BATCH = 32
DEC_SEQ = 64
PAST_LEN = 1024

CHUNK = 64
Q_BLOCK = 128
N_EVEN = (DEPTH + 1) // 2
N_ODD = DEPTH // 2
MLA_HEADS = D_MODEL // 128
QK_NOPE = 64
QK_ROPE = 32
V_HEAD = 64
Q_LORA = D_MODEL // 4
KV_LORA = D_MODEL // 4
ROPE_BASE = 10000.0
MLA_OUT = MLA_HEADS * V_HEAD
CONV_CH = D_MODEL // 2
CONV_K = 3
EVEN_IN = Q_LORA + KV_LORA + QK_ROPE + 3 * CONV_CH
EVEN_SPLITS = (Q_LORA, Q_LORA + KV_LORA, Q_LORA + KV_LORA + QK_ROPE,
               Q_LORA + KV_LORA + QK_ROPE + CONV_CH, Q_LORA + KV_LORA + QK_ROPE + 2 * CONV_CH)
SSM_WIDTH = D_MODEL
SSM_GROUP = 16
SSM_GROUPS = SSM_WIDTH // SSM_GROUP
SSM_STATE = 64
MEM_LEN = 256
X_HEADS = 4
X_HEAD_DIM = D_MODEL // X_HEADS
D_FF = 256 * ((8 * D_MODEL // 3 + 255) // 256)
EPS = 1e-6
NEG_INF = -1e30

kernel_name = 'hybrid_mla_conv_s5_streaming_step'


def rms_norm(x, g):
    x32 = x.astype(jnp.float32)
    y = x32 * lax.rsqrt(jnp.mean(x32 * x32, axis=-1, keepdims=True) + EPS)
    return (y * g.astype(jnp.float32)).astype(x.dtype)


def swiglu(x, w_gu, w_down):
    gate, up = jnp.split(x @ w_gu, 2, axis=-1)
    return (jax.nn.silu(gate) * up) @ w_down


def rope_cos_sin(pos):
    inv = ROPE_BASE ** (-jnp.arange(0, QK_ROPE, 2, dtype=jnp.float32) / QK_ROPE)
    ang = pos.astype(jnp.float32)[:, None] * inv[None, :]
    return jnp.cos(ang), jnp.sin(ang)


def apply_rope(x, cos, sin):
    x32 = x.astype(jnp.float32)
    x1, x2 = jnp.split(x32, 2, axis=-1)
    return jnp.concatenate([x1 * cos - x2 * sin, x1 * sin + x2 * cos], axis=-1).astype(x.dtype)


def chunk_causal_attention(q_nope, q_rope, q_pos, k_nope, k_rope, v, k_pos):
    B, Sq, H, _ = q_nope.shape
    scale = (QK_NOPE + QK_ROPE) ** -0.5
    k_chunk = k_pos // CHUNK

    def attend(args):
        qn, qr, qp = args
        s = jnp.einsum('bqhd,bkhd->bhqk', qn, k_nope) + jnp.einsum('bqhd,bkd->bhqk', qr, k_rope)
        s = s.astype(jnp.float32) * scale
        visible = k_chunk[None, :] <= (qp // CHUNK)[:, None]
        s = jnp.where(visible[None, None], s, NEG_INF)
        p = jax.nn.softmax(s, axis=-1).astype(v.dtype)
        return jnp.einsum('bhqk,bkhd->bqhd', p, v)

    if Sq <= Q_BLOCK:
        return attend((q_nope, q_rope, q_pos))
    nb = Sq // Q_BLOCK

    def to_blocks(t):
        return t.reshape((B, nb, Q_BLOCK) + t.shape[2:]).swapaxes(0, 1)

    out = lax.map(attend, (to_blocks(q_nope), to_blocks(q_rope), q_pos.reshape(nb, Q_BLOCK)))
    return out.swapaxes(0, 1).reshape(B, Sq, H, V_HEAD)


def even_mixer(h, pos, w_in, q_norm, kv_norm, w_uq, w_ukv, conv_w, w_out,
               past_latent, past_krope, past_conv):
    B, S, _ = h.shape
    c_q, c_kv, k_r, gate_b, gate_c, v_in = jnp.split(h @ w_in, EVEN_SPLITS, axis=-1)
    cos, sin = rope_cos_sin(pos)
    q = (rms_norm(c_q, q_norm) @ w_uq).reshape(B, S, MLA_HEADS, QK_NOPE + QK_ROPE)
    q_nope = q[..., :QK_NOPE]
    q_rope = apply_rope(q[..., QK_NOPE:], cos[None, :, None], sin[None, :, None])
    latent = rms_norm(c_kv, kv_norm)
    k_rope = apply_rope(k_r, cos[None], sin[None])
    if past_latent is None:
        lat_all, kr_all, k_pos = latent, k_rope, pos
    else:
        lat_all = jnp.concatenate([past_latent, latent], axis=1)
        kr_all = jnp.concatenate([past_krope, k_rope], axis=1)
        k_pos = jnp.arange(past_latent.shape[1] + S)
    Sk = lat_all.shape[1]
    kv = (lat_all @ w_ukv).reshape(B, Sk, MLA_HEADS, QK_NOPE + V_HEAD)
    k_nope, v = kv[..., :QK_NOPE], kv[..., QK_NOPE:]
    attn = chunk_causal_attention(q_nope, q_rope, pos, k_nope, kr_all, v, k_pos).reshape(B, S, MLA_OUT)
    u = gate_c * v_in
    if past_conv is None:
        past_conv = jnp.zeros((B, CONV_K - 1, CONV_CH), u.dtype)
    u_pad = jnp.concatenate([past_conv, u], axis=1)
    conv = sum(conv_w[k] * u_pad[:, k:k + S] for k in range(CONV_K))
    z = gate_b * conv
    out = jnp.concatenate([attn, z], axis=-1) @ w_out
    return out, latent, k_rope, u_pad[:, -(CONV_K - 1):]


def ssm_mixer(h, w_in, a_re, a_im, b_re, b_im, c_re, c_im, log_dt, d_skip, w_glu, h0_re, h0_im):
    B, S, _ = h.shape
    f32 = jnp.float32
    u = h @ w_in
    u32 = u.astype(f32)
    ug = u32.reshape(B, S, SSM_GROUPS, SSM_GROUP)
    lam = lax.complex(a_re.astype(f32), a_im.astype(f32))
    dt = jnp.exp(log_dt.astype(f32))[:, None]
    a_bar = jnp.exp(lam * dt)
    b_bar = ((a_bar - 1.0) / lam)[..., None] * lax.complex(b_re.astype(f32), b_im.astype(f32))
    c_mat = lax.complex(c_re.astype(f32), c_im.astype(f32))
    bu = lax.complex(jnp.einsum('bsgc,gpc->bsgp', ug, b_bar.real),
                     jnp.einsum('bsgc,gpc->bsgp', ug, b_bar.imag))
    if h0_re is None:
        h0 = jnp.zeros((B, SSM_GROUPS, SSM_STATE), jnp.complex64)
    else:
        h0 = lax.complex(h0_re.astype(f32), h0_im.astype(f32))
    L = CHUNK if S % CHUNK == 0 else S
    nb = S // L
    bu_blocks = bu.reshape(B, nb, L, SSM_GROUPS, SSM_STATE).swapaxes(0, 1)

    def combine(e1, e2):
        a1, b1 = e1
        a2, b2 = e2
        return a1 * a2, a2 * b1 + b2

    def block_step(h_prev, bu_blk):
        bu_blk = bu_blk.at[:, 0].add(a_bar * h_prev)
        a_seq = jnp.broadcast_to(a_bar, bu_blk.shape)
        _, hs = lax.associative_scan(combine, (a_seq, bu_blk), axis=1)
        y = jnp.einsum('blgp,gcp->blgc', hs, c_mat).real
        return hs[:, -1], y

    h_last, ys = lax.scan(block_step, h0, bu_blocks)
    y = ys.swapaxes(0, 1).reshape(B, S, SSM_WIDTH) + d_skip.astype(f32) * u32
    val, gate = jnp.split(jax.nn.gelu(y).astype(h.dtype) @ w_glu, 2, axis=-1)
    out = val * jax.nn.sigmoid(gate)
    return out, h_last.real, h_last.imag


def memory_kv(mem, g, w_k, w_v):
    B = mem.shape[0]
    m = rms_norm(mem, g)
    return ((m @ w_k).reshape(B, MEM_LEN, X_HEADS, X_HEAD_DIM),
            (m @ w_v).reshape(B, MEM_LEN, X_HEADS, X_HEAD_DIM))


def cross_attend(h, mem_k, mem_v, w_q, w_o):
    B, S, _ = h.shape
    q = (h @ w_q).reshape(B, S, X_HEADS, X_HEAD_DIM)
    s = jnp.einsum('bshd,bmhd->bhsm', q, mem_k).astype(jnp.float32) * (X_HEAD_DIM ** -0.5)
    p = jax.nn.softmax(s, axis=-1).astype(mem_v.dtype)
    o = jnp.einsum('bhsm,bmhd->bshd', p, mem_v).reshape(B, S, X_HEADS * X_HEAD_DIM)
    return o @ w_o


def setup_inputs(seed: int = 0) -> dict:
    key = jax.random.key(seed)
    ks = iter(jax.random.split(key, 64))

    def nrm(shape, scale):
        return scale * jax.random.normal(next(ks), shape, jnp.float32)

    def gain(shape):
        return 1.0 + nrm(shape, 0.01)

    D = D_MODEL
    n_idx = jnp.arange(SSM_STATE, dtype=jnp.float32)
    ssm_shape = (N_ODD, SSM_GROUPS, SSM_STATE)
    return {
        'x_prompt': nrm((BATCH, SEQ, D), 1.0),
        'x_sample': nrm((DEC_BATCH, DEC_SEQ, D), 1.0),
        'cache_mla_latent': nrm((N_EVEN, DEC_BATCH, PAST_LEN, KV_LORA), 1.0),
        'cache_mla_krope': nrm((N_EVEN, DEC_BATCH, PAST_LEN, QK_ROPE), 1.0),
        'state_conv': nrm((N_EVEN, DEC_BATCH, CONV_K - 1, CONV_CH), 1.0),
        'state_ssm_re': nrm((N_ODD, DEC_BATCH, SSM_GROUPS, SSM_STATE), 0.3),
        'state_ssm_im': nrm((N_ODD, DEC_BATCH, SSM_GROUPS, SSM_STATE), 0.3),
        'cache_mem_k': nrm((DEPTH, DEC_BATCH, MEM_LEN, X_HEADS, X_HEAD_DIM), 1.0),
        'cache_mem_v': nrm((DEPTH, DEC_BATCH, MEM_LEN, X_HEADS, X_HEAD_DIM), 1.0),
        'mem_prompt': nrm((BATCH, MEM_LEN, D), 1.0),
        'ln_ffn1': gain((DEPTH, D)),
        'w_ffn1_gu': nrm((DEPTH, D, 2 * D_FF), D ** -0.5),
        'w_ffn1_down': nrm((DEPTH, D_FF, D), D_FF ** -0.5),
        'ln_mix': gain((DEPTH, D)),
        'w_in_even': nrm((N_EVEN, D, EVEN_IN), D ** -0.5),
        'q_norm': gain((N_EVEN, Q_LORA)),
        'kv_norm': gain((N_EVEN, KV_LORA)),
        'w_uq': nrm((N_EVEN, Q_LORA, MLA_HEADS * (QK_NOPE + QK_ROPE)), Q_LORA ** -0.5),
        'w_ukv': nrm((N_EVEN, KV_LORA, MLA_HEADS * (QK_NOPE + V_HEAD)), KV_LORA ** -0.5),
        'conv_w': nrm((N_EVEN, CONV_K, CONV_CH), CONV_K ** -0.5),
        'w_out_even': nrm((N_EVEN, MLA_OUT + CONV_CH, D), (MLA_OUT + CONV_CH) ** -0.5),
        'w_in_odd': nrm((N_ODD, D, SSM_WIDTH), D ** -0.5),
        'ssm_a_re': -0.5 + nrm(ssm_shape, 0.01),
        'ssm_a_im': math.pi * n_idx + nrm(ssm_shape, 0.01),
        'ssm_b_re': nrm((N_ODD, SSM_GROUPS, SSM_STATE, SSM_GROUP), (2 * SSM_GROUP) ** -0.5),
        'ssm_b_im': nrm((N_ODD, SSM_GROUPS, SSM_STATE, SSM_GROUP), (2 * SSM_GROUP) ** -0.5),
        'ssm_c_re': nrm((N_ODD, SSM_GROUPS, SSM_GROUP, SSM_STATE), (2 * SSM_STATE) ** -0.5),
        'ssm_c_im': nrm((N_ODD, SSM_GROUPS, SSM_GROUP, SSM_STATE), (2 * SSM_STATE) ** -0.5),
        'ssm_log_dt': jax.random.uniform(next(ks), (N_ODD, SSM_GROUPS), jnp.float32,
                                         math.log(1e-3), math.log(1e-1)),
        'ssm_d': nrm((N_ODD, SSM_WIDTH), 1.0),
        'w_glu': nrm((N_ODD, SSM_WIDTH, 2 * D), SSM_WIDTH ** -0.5),
        'ln_cross': gain((DEPTH, D)),
        'ln_mem': gain((DEPTH, D)),
        'w_xq': nrm((DEPTH, D, X_HEADS * X_HEAD_DIM), D ** -0.5),
        'w_xk': nrm((DEPTH, D, X_HEADS * X_HEAD_DIM), D ** -0.5),
        'w_xv': nrm((DEPTH, D, X_HEADS * X_HEAD_DIM), D ** -0.5),
        'w_xo': nrm((DEPTH, X_HEADS * X_HEAD_DIM, D), (X_HEADS * X_HEAD_DIM) ** -0.5),
        'ln_ffn2': gain((DEPTH, D)),
        'w_ffn2_gu': nrm((DEPTH, D, 2 * D_FF), D ** -0.5),
        'w_ffn2_down': nrm((DEPTH, D_FF, D), D_FF ** -0.5),
        'ln_final': gain((D,)),
    }


def reference(x_prompt, x_sample, cache_mla_latent, cache_mla_krope, state_conv, state_ssm_re, state_ssm_im,
              cache_mem_k, cache_mem_v, mem_prompt,
              ln_ffn1, w_ffn1_gu, w_ffn1_down, ln_mix, w_in_even, q_norm, kv_norm, w_uq, w_ukv, conv_w,
              w_out_even, w_in_odd, ssm_a_re, ssm_a_im, ssm_b_re, ssm_b_im, ssm_c_re, ssm_c_im, ssm_log_dt,
              ssm_d, w_glu, ln_cross, ln_mem, w_xq, w_xk, w_xv, w_xo, ln_ffn2, w_ffn2_gu, w_ffn2_down,
              ln_final):

    def run(x, past, mem_kv):
        B, S, _ = x.shape
        past_len = 0 if past is None else past[0].shape[2]
        pos = past_len + jnp.arange(S)
        lat_new, kr_new, conv_new, sre_new, sim_new = [], [], [], [], []
        for l in range(DEPTH):
            i = l // 2
            x = x + 0.5 * swiglu(rms_norm(x, ln_ffn1[l]), w_ffn1_gu[l], w_ffn1_down[l])
            h = rms_norm(x, ln_mix[l])
            if l % 2 == 0:
                p_lat = p_kr = p_conv = None
                if past is not None:
                    p_lat, p_kr, p_conv = past[0][i], past[1][i], past[2][i]
                mix, lat, kr, cst = even_mixer(h, pos, w_in_even[i], q_norm[i], kv_norm[i], w_uq[i], w_ukv[i],
                                               conv_w[i], w_out_even[i], p_lat, p_kr, p_conv)
                lat_new.append(lat)
                kr_new.append(kr)
                conv_new.append(cst)
            else:
                h0r = h0i = None
                if past is not None:
                    h0r, h0i = past[3][i], past[4][i]
                mix, sre, sim = ssm_mixer(h, w_in_odd[i], ssm_a_re[i], ssm_a_im[i], ssm_b_re[i], ssm_b_im[i],
                                          ssm_c_re[i], ssm_c_im[i], ssm_log_dt[i], ssm_d[i], w_glu[i], h0r, h0i)
                sre_new.append(sre)
                sim_new.append(sim)
            x = x + mix
            mk, mv = mem_kv[l]
            x = x + cross_attend(rms_norm(x, ln_cross[l]), mk, mv, w_xq[l], w_xo[l])
            x = x + 0.5 * swiglu(rms_norm(x, ln_ffn2[l]), w_ffn2_gu[l], w_ffn2_down[l])
        y = rms_norm(x, ln_final)
        return (y, jnp.stack(lat_new), jnp.stack(kr_new), jnp.stack(conv_new),
                jnp.stack(sre_new), jnp.stack(sim_new))

    mem_p = [memory_kv(mem_prompt, ln_mem[l], w_xk[l], w_xv[l]) for l in range(DEPTH)]
    mem_k_p = jnp.stack([kv[0] for kv in mem_p])
    mem_v_p = jnp.stack([kv[1] for kv in mem_p])
    y_prompt, lat_p, kr_p, conv_p, sre_p, sim_p = run(x_prompt, None, mem_p)

    mem_s = [(cache_mem_k[l], cache_mem_v[l]) for l in range(DEPTH)]
    past = (cache_mla_latent, cache_mla_krope, state_conv, state_ssm_re, state_ssm_im)
    y_sample, lat_s, kr_s, conv_s, sre_s, sim_s = run(x_sample, past, mem_s)

    return (y_prompt, y_sample, lat_p, kr_p, conv_p, sre_p, sim_p, mem_k_p, mem_v_p,
            lat_s, kr_s, conv_s, sre_s, sim_s)
```

```cpp
#include <hip/hip_runtime.h>
#include <hip/hip_cooperative_groups.h>
#include <cstdio>
#include <cstdint>
namespace cg = cooperative_groups;

#ifndef MK_PER_PHASE
#define MK_PER_PHASE 0
#endif

#ifndef DBLMASK
#define DBLMASK 0u
#endif
#ifndef PHMASK
#define PHMASK 0xffffffffu
#endif
#define PH_ON(k) (((PHMASK) >> (k)) & 1u)
#define LAS __attribute__((address_space(3)))
typedef unsigned short bf16_t;
typedef short bf16x8 __attribute__((ext_vector_type(8)));
typedef short bf16x4 __attribute__((ext_vector_type(4)));
typedef float f32x4 __attribute__((ext_vector_type(4)));
typedef unsigned u32x4 __attribute__((ext_vector_type(4)));
typedef unsigned u32x2 __attribute__((ext_vector_type(2)));

constexpr int T = 34816, TP = 32768, DM = 1024, FF = 2816, KVROWS = 67584, NCH = 544, UP_LD = 1152, EV_LD = 2304;
constexpr float EPS = 1e-6f;
constexpr int NPHASE = 26;
constexpr size_t XCD_BAR_BYTES = 3456 * 4;
constexpr size_t O_Y = 0, O_LATP = 35651584, O_KRP = O_LATP + 8388608, O_CONVP = O_KRP + 1048576, O_SREP = O_CONVP + 16384, O_SIMP = O_SREP + 65536,
                 O_MKP = O_SIMP + 65536, O_MVP = O_MKP + 8388608, O_LATS = O_MVP + 8388608, O_KRS = O_LATS + 524288, O_CONVS = O_KRS + 65536,
                 O_SRES = O_CONVS + 32768, O_SIMS = O_SRES + 131072, O_END = O_SIMS + 131072;
constexpr size_t al(size_t x) { return (x + 255) & ~(size_t)255; }
constexpr size_t W_GU_A = 0, SZ_GU = (size_t)5632 * 1024 * 2, W_DN_A = W_GU_A + SZ_GU, SZ_DN = (size_t)1024 * 2816 * 2, W_GU_B = W_DN_A + SZ_DN, W_DN_B = W_GU_B + SZ_GU,
                 W_INE = W_DN_B + SZ_DN, W_UQ = W_INE + (size_t)2304 * 1024 * 2, W_UKV = W_UQ + (size_t)768 * 256 * 2, W_OUT = W_UKV + (size_t)1024 * 256 * 2,
                 W_INO = W_OUT + (size_t)1024 * 1024 * 2, W_GLU = W_INO + (size_t)1024 * 1024 * 2, W_XQ = W_GLU + (size_t)2048 * 1024 * 2, W_XO = W_XQ + (size_t)2 * 1024 * 1024 * 2,
                 W_MEM = W_XO + (size_t)2 * 1024 * 1024 * 2, XB = W_MEM + (size_t)4096 * 1024 * 2, SS = XB + (size_t)T * 1024 * 2, SSMEM = SS + (size_t)T * 32 * 4,
                 KLAG = SSMEM + (size_t)4096 * 32 * 4, BIG = KLAG + (size_t)64 * 64 * 256 * 4;
constexpr size_t HBUF = BIG, SZ_HBUF = (size_t)T * FF * 2;
constexpr size_t EVB = BIG, KVB = BIG, CQN = BIG + (size_t)T * EV_LD * 2, LATALL = BIG + SZ_HBUF, KRB = LATALL + (size_t)KVROWS * 256 * 2, QB = KRB + (size_t)KVROWS * 32 * 2,
                 MEMB = QB, MIXCAT = QB + (size_t)T * 768 * 2;
constexpr size_t QX = BIG, ATTX = BIG + (size_t)T * 1024 * 2, KXB = ATTX + (size_t)T * 1024 * 2, VXT = KXB + (size_t)48 * 262144 * 2;
constexpr size_t UPACK = BIG, YBUF = al(BIG + (size_t)64 * NCH * UP_LD * 2), EBUF = YBUF + (size_t)T * 1024 * 2, BTY = BIG + SZ_HBUF, BTE = BTY + (size_t)64 * 1024 * UP_LD * 2;
constexpr size_t WS_BAR = BTE + (size_t)64 * 128 * 1024 * 2 + (size_t)(1 << 20), WS_END = WS_BAR + XCD_BAR_BYTES;
static_assert(CQN + (size_t)T * 256 * 2 <= BIG + SZ_HBUF, "cqn overlaps latall");
static_assert(EBUF + (size_t)64 * NCH * 128 * 4 <= BTY, "ssm bufs overlap");
static_assert(MIXCAT + (size_t)T * 1024 * 2 <= WS_END, "mixcat");

__device__ __forceinline__ unsigned pk2(float lo, float hi) { unsigned r; asm volatile("v_cvt_pk_bf16_f32 %0, %1, %2" : "=v"(r) : "v"(lo), "v"(hi)); return r; }
__device__ __forceinline__ float bf_lo(unsigned w) { return __uint_as_float(w << 16); }
__device__ __forceinline__ float bf_hi(unsigned w) { return __uint_as_float(w & 0xffff0000u); }
__device__ __forceinline__ float bf2f(unsigned short h) { return __uint_as_float((unsigned)h << 16); }
__device__ __forceinline__ unsigned short f2bf(float f) { return (unsigned short)(pk2(f, 0.f) & 0xffffu); }
__device__ __forceinline__ float red_sum16(float x) { const auto r = __builtin_amdgcn_permlane16_swap(__float_as_uint(x), __float_as_uint(x), false, false); return __uint_as_float(r[0]) + __uint_as_float(r[1]); }
__device__ __forceinline__ float red_sum32(float x) { const auto r = __builtin_amdgcn_permlane32_swap(__float_as_uint(x), __float_as_uint(x), false, false); return __uint_as_float(r[0]) + __uint_as_float(r[1]); }
__device__ __forceinline__ float red_max16(float x) { const auto r = __builtin_amdgcn_permlane16_swap(__float_as_uint(x), __float_as_uint(x), false, false); return fmaxf(__uint_as_float(r[0]), __uint_as_float(r[1])); }
__device__ __forceinline__ float red_max32(float x) { const auto r = __builtin_amdgcn_permlane32_swap(__float_as_uint(x), __float_as_uint(x), false, false); return fmaxf(__uint_as_float(r[0]), __uint_as_float(r[1])); }
__device__ __forceinline__ float wave_sum(float v) {
#pragma unroll
    for (int o = 1; o < 16; o <<= 1) v += __shfl_xor(v, o);
    return red_sum32(red_sum16(v));
}
__device__ __forceinline__ float lane_xor32(float x, int fq) { const auto r = __builtin_amdgcn_permlane32_swap(__float_as_uint(x), __float_as_uint(x), false, false); return __uint_as_float(fq < 2 ? r[1] : r[0]); }
__device__ __forceinline__ float fast_rcp(float x) { return __builtin_amdgcn_rcpf(x); }
__device__ __forceinline__ float fast_exp(float x) { return __builtin_amdgcn_exp2f(x * 1.44269504f); }
__device__ __forceinline__ float sigmoidf_(float x) { return fast_rcp(1.0f + fast_exp(-x)); }
__device__ __forceinline__ float rope_ift(int ii) { return __builtin_amdgcn_exp2f(-(float)ii * 0.83048202f) * 0.15915494f; }
__device__ __forceinline__ void cis_turns(float t, float& c, float& s) { t = t - floorf(t); c = __builtin_amdgcn_cosf(t); s = __builtin_amdgcn_sinf(t); }
__device__ __forceinline__ void cpow(float are, float aim, float dt, float d, float& pr, float& pi) {
    const float mag = __expf(d * are * dt); float c, s; cis_turns(d * (aim * dt * 0.15915494f), c, s); pr = mag * c; pi = mag * s;
}
__device__ __forceinline__ float row_rstd(const float* ss, int row, int fq, int np) {
    float s;
    if (np == 16) { const f32x4 v = *(const f32x4*)(ss + (size_t)row * 32 + 4 * fq); s = (v.x + v.y) + (v.z + v.w); }
    else { const f32x4 v = *(const f32x4*)(ss + (size_t)row * 32 + 8 * fq), w = *(const f32x4*)(ss + (size_t)row * 32 + 8 * fq + 4); s = ((v.x + v.y) + (v.z + v.w)) + ((w.x + w.y) + (w.z + w.w)); }
    s = red_sum32(red_sum16(s));
    return rsqrtf(s * (1.0f / 1024.0f) + EPS);
}


#define XB_TMO      128
#define XB_XCNT(j)  (256  + 64 * (j))
#define XB_XSUB(j)  (1280 + 64 * (j))
#define XB_XGEN(j)  (2304 + 64 * (j))
#define XB_TOP      3328
#define XB_TOPGEN   3392
#define XCD_BAR_WORDS 3456
#define XB_SPIN_CAP (1u << 18)
__device__ __forceinline__ unsigned xb_ld(unsigned* p)              { return __hip_atomic_load(p, __ATOMIC_RELAXED, __HIP_MEMORY_SCOPE_AGENT); }
__device__ __forceinline__ unsigned xb_add(unsigned* p, unsigned v) { return __hip_atomic_fetch_add(p, v, __ATOMIC_RELAXED, __HIP_MEMORY_SCOPE_AGENT); }
__device__ __forceinline__ unsigned xb_xcc_id() { return (unsigned)__builtin_amdgcn_s_getreg((3 << 11) | 20) & 0xFu; }
#define XB_SPIN(cond, bar) do { unsigned _sp = 0; while (cond) { __builtin_amdgcn_s_sleep(1); \
    if ((++_sp & 255u) == 0u) { if (xb_ld(&(bar)[XB_TMO])) break; if (_sp > XB_SPIN_CAP) { atomicAdd(&(bar)[XB_TMO], 1u); break; } } } } while (0)
struct XcdBarrier { unsigned* bar; unsigned x; volatile LAS unsigned* st; };
__device__ __forceinline__ XcdBarrier xcd_barrier_post(unsigned* bar, volatile LAS unsigned* st) {
    XcdBarrier b; b.bar = bar; b.x = xb_xcc_id(); b.st = st;
    if (threadIdx.x == 0) (void)xb_add(&bar[XB_XCNT(b.x)], 1u);
    return b;
}
__device__ __forceinline__ void xcd_barrier_complete(unsigned* bar, unsigned x, unsigned& nloc, unsigned& nx) {
    const unsigned G = gridDim.x * gridDim.y * gridDim.z;
    unsigned sum, cnt, mine, sp = 0u;
    for (;;) {
        sum = 0u; cnt = 0u; mine = 0u;
#pragma unroll
        for (unsigned j = 0; j < 16; ++j) { const unsigned c = xb_ld(&bar[XB_XCNT(j)]); sum += c; cnt += (c > 0u) ? 1u : 0u; mine = (j == x) ? c : mine; }
        if (sum == G) break;
        __builtin_amdgcn_s_sleep(1);
        if ((++sp & 255u) == 0u) { if (xb_ld(&bar[XB_TMO])) break; if (sp > XB_SPIN_CAP) { atomicAdd(&bar[XB_TMO], 1u); break; } }
    }
    nloc = mine > 0u ? mine : 1u; nx = cnt > 0u ? cnt : 1u;
}
__device__ __forceinline__ void xcd_barrier(const XcdBarrier& b) {
    asm volatile("s_waitcnt vmcnt(0)" ::: "memory");
    __syncthreads();
    if (threadIdx.x == 0) {
        unsigned* bar = b.bar;
        __builtin_amdgcn_s_waitcnt(0);
        unsigned nloc = b.st[0], nx = b.st[1];
        if (nloc == 0u) { xcd_barrier_complete(bar, b.x, nloc, nx); b.st[0] = nloc; b.st[1] = nx; }
        const unsigned old = xb_add(&bar[XB_XSUB(b.x)], 1u);
        const unsigned gen = old / nloc;
        if (old + 1u == (gen + 1u) * nloc) {
            __builtin_amdgcn_fence(__ATOMIC_RELEASE, "agent");
            asm volatile("s_waitcnt vmcnt(0)" ::: "memory");
            const unsigned og = xb_add(&bar[XB_TOP], 1u);
            const unsigned tg = og / nx;
            if (og + 1u == (tg + 1u) * nx) xb_add(&bar[XB_TOPGEN], 1u);
            else XB_SPIN(xb_ld(&bar[XB_TOPGEN]) == tg, bar);
            __builtin_amdgcn_fence(__ATOMIC_ACQUIRE, "agent");
            xb_add(&bar[XB_XGEN(b.x)], 1u);
            asm volatile("s_waitcnt vmcnt(0)" ::: "memory");
        } else {
            XB_SPIN(xb_ld(&bar[XB_XGEN(b.x)]) == gen, bar);
            __builtin_amdgcn_fence(__ATOMIC_ACQUIRE, "agent");
            asm volatile("s_waitcnt vmcnt(0)" ::: "memory");
        }
    }
    __syncthreads();
}

__device__ __forceinline__ void row_rstd8(const float* ss, int row0, int fq, int np, float (&rs)[2][4]) {
    float sv[2][4];
#pragma unroll
    for (int ai = 0; ai < 2; ++ai)
#pragma unroll
        for (int m = 0; m < 4; ++m) { const int row = row0 + ai * 128 + m * 16;
            if (np == 16) { const f32x4 v = *(const f32x4*)(ss + (size_t)row * 32 + 4 * fq); sv[ai][m] = (v.x + v.y) + (v.z + v.w); }
            else { const f32x4 v = *(const f32x4*)(ss + (size_t)row * 32 + 8 * fq), w = *(const f32x4*)(ss + (size_t)row * 32 + 8 * fq + 4); sv[ai][m] = ((v.x + v.y) + (v.z + v.w)) + ((w.x + w.y) + (w.z + w.w)); } }
#pragma unroll
    for (int ai = 0; ai < 2; ++ai)
#pragma unroll
        for (int m = 0; m < 4; ++m) { const float t = red_sum32(red_sum16(sv[ai][m])); rs[ai][m] = rsqrtf(t * (1.0f / 1024.0f) + EPS); }
}

namespace pg8 {
constexpr int BM = 256, BK = 64, HALF = 128, HTB = HALF * BK * 2, STAGE_BYTES = 8 * HTB;
__device__ __forceinline__ int lds_byte(int r, int c) { const int st = (r >> 4) * 2 + (c >> 5), rr = r & 15, cc = c & 31, ob = rr * 64 + cc * 2; return st * 1024 + (ob ^ (((ob >> 9) & 1) << 5)); }
__device__ __forceinline__ void stage_rc(int b, int& R, int& C) { const int st = b / 1024, sb = b % 1024, swz = sb ^ (((sb >> 9) & 1) << 5); R = (st >> 1) * 16 + swz / 64; C = (st & 1) * 32 + (swz % 64) / 2; }
__device__ __forceinline__ int perm32(int rho) { const int n = rho >> 4, i = rho & 15; return 8 * (i >> 2) + 4 * n + (i & 3); }
struct Unit { int pm, pn, pb; };
struct Gemm { const bf16_t* A; const bf16_t* Bt; int lda, ldb, K, nM, nN, nB; long sA, sB; int tri, amode, order, rot; };
__device__ __forceinline__ void remap_tile(int wgid, int nM, int nN, int& pm, int& pn) {
    const int nwg = nM * nN;
    { const int q = nwg / 8, r = nwg % 8, xcd = wgid % 8, off = wgid / 8; wgid = (xcd < r ? xcd * (q + 1) : r * (q + 1) + (xcd - r) * q) + off; }
    const int nig = 8 * nN, gid = wgid / nig, fm = gid * 8, gsz = (nM - fm) < 8 ? (nM - fm) : 8;
    pm = fm + ((wgid % nig) % gsz); pn = (wgid % nig) / gsz;
}
__device__ __forceinline__ bool next_unit(const Gemm& g, int i, Unit& u) {
    if (g.order) {
        const int c = (int)blockIdx.x; u.pb = 0; int p = -1;
        if (g.order == 1) { if (i) return false; if (c < 176) { u.pm = 128 + c / 22; u.pn = c % 22; return true; } p = c; }
        else if (g.order == 2) {
            if (c < 176) { if (i > 10) return false; p = i * 256 + c; }
            else if (c < 208) { if (i > 10) return false; p = i < 10 ? (i + 1) * 256 + c : 10 * 256 + c + 48; }
            else if (c < 224) { if (i > 9) return false; p = (i + 1) * 256 + c; }
            else { if (i > 8) return false; p = (i + 1) * 256 + c; }
        } else { if (i || c < 224) return false; const int t = c - 224; u.pm = 128 + (t >> 2); u.pn = t & 3; return true; }
        remap_tile(p, 128, 22, u.pm, u.pn); return true;
    }
    const int nwg = g.nM * g.nN;
    if (g.nB > 1) {
        const int G8 = (int)gridDim.x >> 3, x = (int)blockIdx.x & 7, q = i * G8 + ((int)blockIdx.x >> 3), gi = q / nwg, pb = x + 8 * gi;
        if ((gridDim.x & 7) != 0 || pb >= g.nB) { if ((gridDim.x & 7) == 0) return false; }
        else { const int r = q % nwg; u.pb = pb; u.pm = r / g.nN; u.pn = (r % g.nN + (g.tri ? i : 0)) % g.nN; return true; }
    }
    const long L = (long)i * gridDim.x + (blockIdx.x + (unsigned)g.rot) % gridDim.x; if (L >= (long)nwg * g.nB) return false;
    u.pb = (int)(L / nwg); int wgid = (int)(L % nwg);
    { const int q = nwg / 8, r = nwg % 8, xcd = wgid % 8, off = wgid / 8; wgid = (xcd < r ? xcd * (q + 1) : r * (q + 1) + (xcd - r) * q) + off; }
    const int nig = 8 * g.nN, gid = wgid / nig, fm = gid * 8, gsz = (g.nM - fm) < 8 ? (g.nM - fm) : 8;
    u.pm = fm + ((wgid % nig) % gsz); u.pn = (wgid % nig) / gsz; return true;
}
template <class Epi>
__device__ __forceinline__ void gemm_phase(LAS unsigned char* lds, const Gemm g, const Epi& E) {
    const int tid = threadIdx.x, wid = __builtin_amdgcn_readfirstlane(tid >> 6), lane = tid & 63, wr = wid >> 2, wc = wid & 3, fr = lane & 15, fq = lane >> 4;
    int nt_all = g.K / BK; asm volatile("" : "+s"(nt_all));
    unsigned voffA[2], voffB[2];
#pragma unroll
    for (int i = 0; i < 2; ++i) { int R, C; stage_rc(tid * 16 + i * 8192, R, C); const int Rb = (R & ~31) + perm32(R & 31);
        voffA[i] = g.amode ? (unsigned)(((size_t)(C >> 4) * g.sA + R * 16 + (C & 15)) * 2) : (unsigned)(R * g.lda + C) * 2u; voffB[i] = (unsigned)(Rb * g.ldb + C) * 2u; }
    const size_t kstep = (size_t)(BK * 2), kstepA = g.amode ? (size_t)g.sA * 8 : kstep;
    const size_t hsA = (size_t)HALF * g.lda * 2, hsB = (size_t)HALF * g.ldb * 2;
    const unsigned ldsw = (unsigned)wid * 1024u;
    const int aoff = lds_byte(wr * 64 + fr, fq * 8), boff = lds_byte(wc * 32 + fr, fq * 8);
#define PG8_SA(b, h) (((b) * 2 + (h)) * HTB)
#define PG8_SB(b, h) ((4 + (b) * 2 + (h)) * HTB)
#define PG8_STAGE(bufoff, gbase, voff) do { _Pragma("unroll") for (int _i = 0; _i < 2; ++_i) \
        __builtin_amdgcn_global_load_lds((const unsigned*)((const char*)(gbase) + (voff)[_i]), (LAS unsigned*)(lds + (bufoff) + ldsw + _i * 8192), 16, 0, 0); } while (0)
#define PG8_LDA(dst, b, h) do { _Pragma("unroll") for (int m = 0; m < 4; ++m) _Pragma("unroll") for (int k = 0; k < 2; ++k) dst[m][k] = *(const LAS bf16x8*)(lds + PG8_SA(b, h) + aoff + m * 2048 + k * 1024); } while (0)
#define PG8_LDB(dst, b, h) do { _Pragma("unroll") for (int n = 0; n < 2; ++n) _Pragma("unroll") for (int k = 0; k < 2; ++k) dst[n][k] = *(const LAS bf16x8*)(lds + PG8_SB(b, h) + boff + n * 2048 + k * 1024); } while (0)
#define PG8_MMA(ai, bj, At, Bt) do { __builtin_amdgcn_s_setprio(1); _Pragma("unroll") for (int m = 0; m < 4; ++m) _Pragma("unroll") for (int n = 0; n < 2; ++n) _Pragma("unroll") for (int k = 0; k < 2; ++k) \
        acc[ai][bj][m][n] = __builtin_amdgcn_mfma_f32_16x16x32_bf16(Bt[n][k], At[m][k], acc[ai][bj][m][n], 0, 0, 0); __builtin_amdgcn_s_setprio(0); } while (0)
#define PG8_WAIT_V(n) asm volatile("s_waitcnt vmcnt(" #n ")" ::: "memory")
#define PG8_WAIT_L(n) asm volatile("s_waitcnt lgkmcnt(" #n ")" ::: "memory")
#define PG8_BAR __builtin_amdgcn_s_barrier()
#define PG8_SCHED __builtin_amdgcn_sched_barrier(0)
    Unit cur, nxt; int ui = 0;
    if (!next_unit(g, 0, cur)) return;
    f32x4 acc[2][2][4][2];
#pragma unroll
    for (int a = 0; a < 2; ++a)
#pragma unroll
        for (int b = 0; b < 2; ++b)
#pragma unroll
            for (int m = 0; m < 4; ++m)
#pragma unroll
                for (int n = 0; n < 2; ++n) acc[a][b][m][n] = (f32x4){0.f, 0.f, 0.f, 0.f};
    bf16x8 At[4][2], B0[2][2], B1[2][2];
    const char* cA = (const char*)g.A + ((size_t)cur.pb * g.sA + (size_t)cur.pm * BM * g.lda) * 2; const char* cB = (const char*)g.Bt + ((size_t)cur.pb * g.sB + (size_t)cur.pn * BM * g.ldb) * 2;
    PG8_STAGE(PG8_SB(0, 0), cB, voffB); PG8_STAGE(PG8_SB(0, 1), cB + hsB, voffB); PG8_STAGE(PG8_SA(0, 0), cA, voffA); PG8_STAGE(PG8_SA(0, 1), cA + hsA, voffA);
    if (wr == 1) PG8_BAR;
    PG8_WAIT_V(2); PG8_BAR;
    PG8_STAGE(PG8_SB(1, 0), cB + kstep, voffB); PG8_STAGE(PG8_SA(1, 0), cA + kstepA, voffA); PG8_STAGE(PG8_SB(1, 1), cB + hsB + kstep, voffB);
    PG8_WAIT_V(6); PG8_BAR;
    for (;;) {
        const bool has_next = next_unit(g, ui + 1, nxt);
        const char* nA = has_next ? (const char*)g.A + ((size_t)nxt.pb * g.sA + (size_t)nxt.pm * BM * g.lda) * 2 : cA;
        const char* nB = has_next ? (const char*)g.Bt + ((size_t)nxt.pb * g.sB + (size_t)nxt.pn * BM * g.ldb) * 2 : cB;
        const int nt = g.tri ? min(nt_all, 6 + 4 * cur.pn) : nt_all;
        for (int t = 0; t < nt; t += 2) {
            const bool last = (t == nt - 2);
            const char* a1 = cA + (size_t)(t + 1) * kstepA;
            const char* a2 = last ? nA : cA + (size_t)(t + 2) * kstepA; const char* b2 = last ? nB : cB + (size_t)(t + 2) * kstep;
            const char* a3 = a2 + kstepA; const char* b3 = b2 + kstep;
            PG8_LDB(B0, 0, 0); PG8_LDB(B1, 0, 1); PG8_SCHED; PG8_LDA(At, 0, 0); PG8_STAGE(PG8_SA(1, 1), a1 + hsA, voffA);
            PG8_WAIT_V(8); PG8_WAIT_L(0); PG8_BAR; PG8_MMA(0, 0, At, B0); PG8_MMA(0, 1, At, B1); PG8_BAR; PG8_SCHED;
            PG8_LDA(At, 0, 1); PG8_STAGE(PG8_SB(0, 0), b2, voffB); PG8_STAGE(PG8_SB(0, 1), b2 + hsB, voffB); PG8_STAGE(PG8_SA(0, 0), a2, voffA);
            PG8_WAIT_V(8); PG8_WAIT_L(0); PG8_BAR; PG8_MMA(1, 0, At, B0); PG8_MMA(1, 1, At, B1); PG8_BAR; PG8_SCHED;
            PG8_LDB(B0, 1, 0); PG8_LDB(B1, 1, 1); PG8_SCHED; PG8_LDA(At, 1, 0); PG8_STAGE(PG8_SA(0, 1), a2 + hsA, voffA);
            PG8_WAIT_V(8); PG8_WAIT_L(0); PG8_BAR; PG8_MMA(0, 0, At, B0); PG8_MMA(0, 1, At, B1); PG8_BAR; PG8_SCHED;
            PG8_LDA(At, 1, 1); PG8_STAGE(PG8_SB(1, 0), b3, voffB); PG8_STAGE(PG8_SB(1, 1), b3 + hsB, voffB); PG8_STAGE(PG8_SA(1, 0), a3, voffA);
            PG8_WAIT_V(8); PG8_WAIT_L(0); PG8_BAR; PG8_MMA(1, 0, At, B0); PG8_MMA(1, 1, At, B1); PG8_BAR; PG8_SCHED;
        }
        if (wr == 0) PG8_BAR;
        E(acc, cur, wr, wc, fr, fq);
        if (!has_next) break;
#pragma unroll
        for (int a = 0; a < 2; ++a)
#pragma unroll
            for (int b = 0; b < 2; ++b)
#pragma unroll
                for (int m = 0; m < 4; ++m)
#pragma unroll
                    for (int n = 0; n < 2; ++n) acc[a][b][m][n] = (f32x4){0.f, 0.f, 0.f, 0.f};
        cur = nxt; cA = nA; cB = nB; ++ui;
        if (wr == 1) PG8_BAR;
    }
    PG8_WAIT_V(0);
    PG8_BAR;
#undef PG8_SA
#undef PG8_SB
#undef PG8_STAGE
#undef PG8_LDA
#undef PG8_LDB
#undef PG8_MMA
#undef PG8_WAIT_V
#undef PG8_WAIT_L
#undef PG8_BAR
#undef PG8_SCHED
}
typedef f32x4 Acc[2][2][4][2];

struct EpiSwiglu { bf16_t* H; const float* ss; int np;
    __device__ __forceinline__ void operator()(const Acc& acc, const Unit& u, int wr, int wc, int fr, int fq) const {
        const int row0 = u.pm * BM + wr * 64 + fr, col0 = u.pn * 128 + wc * 32 + 8 * fq;
        float rsv[2][4]; row_rstd8(ss, row0, fq, np, rsv);
#pragma unroll
        for (int ai = 0; ai < 2; ++ai)
#pragma unroll
            for (int m = 0; m < 4; ++m) { const int row = row0 + ai * HALF + m * 16; const float rs = rsv[ai][m];
                float h[8];
#pragma unroll
                for (int n = 0; n < 2; ++n)
#pragma unroll
                    for (int j = 0; j < 4; ++j) { const float gt = acc[ai][0][m][n][j] * rs, up = acc[ai][1][m][n][j] * rs; h[n * 4 + j] = gt * sigmoidf_(gt) * up; }
                u32x4 w; w.x = pk2(h[0], h[1]); w.y = pk2(h[2], h[3]); w.z = pk2(h[4], h[5]); w.w = pk2(h[6], h[7]);
                __builtin_nontemporal_store(w, (u32x4*)(H + (size_t)row * FF + col0)); }
    }
};
struct EpiResid { bf16_t* XBp; float* ss; float alpha;
    __device__ __forceinline__ void operator()(const Acc& acc, const Unit& u, int wr, int wc, int fr, int fq) const {
        const int row0 = u.pm * BM + wr * 64 + fr, col0 = u.pn * BM + wc * 32 + 8 * fq;
#pragma unroll
        for (int ai = 0; ai < 2; ++ai) {
            u32x4 xo[4][2];
#pragma unroll
            for (int m = 0; m < 4; ++m)
#pragma unroll
                for (int bj = 0; bj < 2; ++bj) xo[m][bj] = *(const u32x4*)(XBp + (size_t)(row0 + ai * HALF + m * 16) * DM + col0 + bj * HALF);
#pragma unroll
            for (int m = 0; m < 4; ++m) { const int row = row0 + ai * HALF + m * 16; float sq = 0.f;
#pragma unroll
                for (int bj = 0; bj < 2; ++bj) { bf16_t* p = XBp + (size_t)row * DM + col0 + bj * HALF; const u32x4 xv = xo[m][bj];
                    f32x4 x0 = (f32x4){bf_lo(xv.x), bf_hi(xv.x), bf_lo(xv.y), bf_hi(xv.y)}, x1 = (f32x4){bf_lo(xv.z), bf_hi(xv.z), bf_lo(xv.w), bf_hi(xv.w)};
                    x0 = x0 + alpha * acc[ai][bj][m][0]; x1 = x1 + alpha * acc[ai][bj][m][1];
                    u32x4 w; w.x = pk2(x0.x, x0.y); w.y = pk2(x0.z, x0.w); w.z = pk2(x1.x, x1.y); w.w = pk2(x1.z, x1.w);
                    *(u32x4*)p = w;
                    sq += (x0.x * x0.x + x0.y * x0.y) + (x0.z * x0.z + x0.w * x0.w) + (x1.x * x1.x + x1.y * x1.y) + (x1.z * x1.z + x1.w * x1.w); }
                sq = red_sum32(red_sum16(sq));
                if (fq == 0) ss[(size_t)row * 32 + u.pn * 4 + wc] = sq; }
        }
    }
};
struct EpiGluResid { bf16_t* XBp; float* ss; float mul;
    __device__ __forceinline__ void operator()(const Acc& acc, const Unit& u, int wr, int wc, int fr, int fq) const {
        const int row0 = u.pm * BM + wr * 64 + fr, col0 = u.pn * 128 + wc * 32 + 8 * fq;
        u32x4 xo[2][4];
#pragma unroll
        for (int ai = 0; ai < 2; ++ai)
#pragma unroll
            for (int m = 0; m < 4; ++m) xo[ai][m] = *(const u32x4*)(XBp + (size_t)(row0 + ai * HALF + m * 16) * DM + col0);
#pragma unroll
        for (int ai = 0; ai < 2; ++ai)
#pragma unroll
            for (int m = 0; m < 4; ++m) { const int row = row0 + ai * HALF + m * 16; bf16_t* p = XBp + (size_t)row * DM + col0; const u32x4 xv = xo[ai][m];
                f32x4 x0 = (f32x4){bf_lo(xv.x), bf_hi(xv.x), bf_lo(xv.y), bf_hi(xv.y)}, x1 = (f32x4){bf_lo(xv.z), bf_hi(xv.z), bf_lo(xv.w), bf_hi(xv.w)};
#pragma unroll
                for (int j = 0; j < 4; ++j) { x0[j] += mul * acc[ai][0][m][0][j] * sigmoidf_(acc[ai][1][m][0][j]); x1[j] += mul * acc[ai][0][m][1][j] * sigmoidf_(acc[ai][1][m][1][j]); }
                u32x4 w; w.x = pk2(x0.x, x0.y); w.y = pk2(x0.z, x0.w); w.z = pk2(x1.x, x1.y); w.w = pk2(x1.z, x1.w);
                *(u32x4*)p = w;
                float sq = (x0.x * x0.x + x0.y * x0.y) + (x0.z * x0.z + x0.w * x0.w) + (x1.x * x1.x + x1.y * x1.y) + (x1.z * x1.z + x1.w * x1.w);
                sq = red_sum32(red_sum16(sq));
                if (fq == 0) ss[(size_t)row * 32 + u.pn * 4 + wc] = sq; }
    }
};
template <bool SCALE> struct EpiBf { bf16_t* O; int ldc; const float* ss; int np; float mul;
    __device__ __forceinline__ void operator()(const Acc& acc, const Unit& u, int wr, int wc, int fr, int fq) const {
        const int row0 = u.pm * BM + wr * 64 + fr, col0 = u.pn * BM + wc * 32 + 8 * fq;
        float rsv[2][4]; if (SCALE) row_rstd8(ss, row0, fq, np, rsv);
#pragma unroll
        for (int ai = 0; ai < 2; ++ai)
#pragma unroll
            for (int m = 0; m < 4; ++m) { const int row = row0 + ai * HALF + m * 16; float rs = mul; if (SCALE) rs *= rsv[ai][m];
#pragma unroll
                for (int bj = 0; bj < 2; ++bj) { const f32x4 v0 = acc[ai][bj][m][0] * rs, v1 = acc[ai][bj][m][1] * rs;
                    u32x4 w; w.x = pk2(v0.x, v0.y); w.y = pk2(v0.z, v0.w); w.z = pk2(v1.x, v1.y); w.w = pk2(v1.z, v1.w);
                    *(u32x4*)(O + (size_t)row * ldc + col0 + bj * HALF) = w; } }
    }
};
struct EpiU { bf16_t* U; const float* ss; int np;
    __device__ __forceinline__ void operator()(const Acc& acc, const Unit& u, int wr, int wc, int fr, int fq) const {
        const int row0 = u.pm * BM + wr * 64 + fr, col0 = u.pn * BM + wc * 32 + 8 * fq;
        float rsv[2][4]; row_rstd8(ss, row0, fq, np, rsv);
#pragma unroll
        for (int ai = 0; ai < 2; ++ai)
#pragma unroll
            for (int m = 0; m < 4; ++m) { const int row = row0 + ai * HALF + m * 16; const float rs = rsv[ai][m]; const int chunk = row >> 6, j = row & 63;
#pragma unroll
                for (int bj = 0; bj < 2; ++bj) { const int col = col0 + bj * HALF, gg = col >> 4, cp = col & 15; const f32x4 v0 = acc[ai][bj][m][0] * rs, v1 = acc[ai][bj][m][1] * rs;
                    u32x4 w; w.x = pk2(v0.x, v0.y); w.y = pk2(v0.z, v0.w); w.z = pk2(v1.x, v1.y); w.w = pk2(v1.z, v1.w);
                    *(u32x4*)(U + ((size_t)gg * NCH + chunk) * UP_LD + 128 + j * 16 + cp) = w; } }
    }
};
struct EpiMemKV { float* out; const float* ss;
    __device__ __forceinline__ void operator()(const Acc& acc, const Unit& u, int wr, int wc, int fr, int fq) const {
        const int row0 = u.pm * BM + wr * 64 + fr, l = u.pn >> 3, kv = (u.pn >> 2) & 1, col0 = (u.pn & 3) * BM + wc * 32 + 8 * fq;
        float* base = out + (kv ? O_MVP : O_MKP) + (size_t)l * 4096 * 1024;
#pragma unroll
        for (int ai = 0; ai < 2; ++ai)
#pragma unroll
            for (int m = 0; m < 4; ++m) { const int row = row0 + ai * HALF + m * 16; const float rs = row_rstd(ss, row, fq, 16);
#pragma unroll
                for (int bj = 0; bj < 2; ++bj) { float* p = base + (size_t)row * 1024 + col0 + bj * HALF; *(f32x4*)p = acc[ai][bj][m][0] * rs; *(f32x4*)(p + 4) = acc[ai][bj][m][1] * rs; } }
    }
};
struct EpiE { float* Eo;
    __device__ __forceinline__ void operator()(const Acc& acc, const Unit& u, int wr, int wc, int fr, int fq) const {
        const int row0 = u.pm * BM + wr * 64 + fr, col0 = wc * 32 + 8 * fq;
#pragma unroll
        for (int ai = 0; ai < 2; ++ai)
#pragma unroll
            for (int m = 0; m < 4; ++m) { const int row = row0 + ai * HALF + m * 16;
                if (row < NCH) { float* p = Eo + ((size_t)u.pb * NCH + row) * 128 + col0; *(f32x4*)p = acc[ai][0][m][0]; *(f32x4*)(p + 4) = acc[ai][0][m][1]; } }
    }
};
struct EpiY { bf16_t* Y; const bf16_t* U; const float* dsk;
    __device__ __forceinline__ void operator()(const Acc& acc, const Unit& u, int wr, int wc, int fr, int fq) const {
        const int row0 = u.pm * BM + wr * 64 + fr, col0 = u.pn * BM + wc * 32 + 8 * fq, c = col0 & 15;
        const f32x4 d0 = *(const f32x4*)(dsk + u.pb * 16 + c), d1 = *(const f32x4*)(dsk + u.pb * 16 + c + 4);
        u32x4 uv[2][4][2];
#pragma unroll
        for (int ai = 0; ai < 2; ++ai)
#pragma unroll
            for (int m = 0; m < 4; ++m)
#pragma unroll
                for (int bj = 0; bj < 2; ++bj) { const int row = min(row0 + ai * HALF + m * 16, NCH - 1); uv[ai][m][bj] = *(const u32x4*)(U + ((size_t)u.pb * NCH + row) * UP_LD + 128 + col0 + bj * HALF); }
#pragma unroll
        for (int ai = 0; ai < 2; ++ai)
#pragma unroll
            for (int m = 0; m < 4; ++m) { const int row = row0 + ai * HALF + m * 16;
                if (row < NCH) {
#pragma unroll
                    for (int bj = 0; bj < 2; ++bj) { const int n = col0 + bj * HALF, l = n >> 4;
                        const u32x4 uu = uv[ai][m][bj];
                        float y[8];
                        y[0] = acc[ai][bj][m][0].x + d0.x * bf_lo(uu.x); y[1] = acc[ai][bj][m][0].y + d0.y * bf_hi(uu.x); y[2] = acc[ai][bj][m][0].z + d0.z * bf_lo(uu.y); y[3] = acc[ai][bj][m][0].w + d0.w * bf_hi(uu.y);
                        y[4] = acc[ai][bj][m][1].x + d1.x * bf_lo(uu.z); y[5] = acc[ai][bj][m][1].y + d1.y * bf_hi(uu.z); y[6] = acc[ai][bj][m][1].z + d1.z * bf_lo(uu.w); y[7] = acc[ai][bj][m][1].w + d1.w * bf_hi(uu.w);
#pragma unroll
                        for (int j = 0; j < 8; ++j) { const float v = y[j], z = 1.59576912f * (v + 0.044715f * v * v * v); y[j] = v * sigmoidf_(z); }
                        u32x4 w; w.x = pk2(y[0], y[1]); w.y = pk2(y[2], y[3]); w.z = pk2(y[4], y[5]); w.w = pk2(y[6], y[7]);
                        *(u32x4*)(Y + ((size_t)u.pb * T + (size_t)row * 64 + l) * 16 + c) = w; } } }
    }
};
}

template <int MODE>
__device__ __forceinline__ void attn_phase(LAS unsigned char* lds, const bf16_t* Q, const bf16_t* kvb, const bf16_t* krb, const bf16_t* kxb, const bf16_t* vxt, bf16_t* O) {
    constexpr int DQK = MODE ? 256 : 96, DV = MODE ? 256 : 64, KSTR = DQK + 8, VSTR = 72, NKS = DQK / 32, NDB = DV / 16, LDQ = MODE ? 1024 : 768;
    constexpr int HALF_BYTES = 64 * KSTR * 2 + DV * VSTR * 2, NITEM = MODE ? 1152 : 2304, NKR = MODE ? 4 : 2, NVR = MODE ? 4 : 1, NDW = NDB;
    const int tid = threadIdx.x, wid = __builtin_amdgcn_readfirstlane(tid >> 6), lane = tid & 63, w = wid, th = tid, fr = lane & 15, fq = lane >> 4;
    LAS bf16_t* Ks = (LAS bf16_t*)lds; LAS bf16_t* Vt = Ks + 64 * KSTR;
    for (int rnd = 0; rnd * (int)gridDim.x < NITEM; ++rnd) {
        const int it = rnd * (int)gridDim.x + ((MODE == 0 && (rnd & 1)) ? ((int)gridDim.x - 1 - (int)blockIdx.x) : (int)blockIdx.x);
        if (it >= NITEM) continue;
        int qrow0, ntiles, h, kvrow0 = 0, pos0 = 0, wq = w; bool wactive = true; const bf16_t* kbase = nullptr; const bf16_t* vbase = nullptr;
        int my_nt = 0;
        if (MODE == 0) {
            int L = it, b, j = -1;
            if (L < 1024) { j = 15 - (L >> 7); b = (L & 127) >> 3; h = L & 7; }
            else if (L < 1280) { L -= 1024; b = L >> 3; h = L & 7; }
            else { L -= 1280; j = 7 - (L >> 7); b = (L & 127) >> 3; h = L & 7; }
            if (j >= 0) { qrow0 = b * 2048 + 128 * j; kvrow0 = b * 2048; ntiles = 2 * j + 2; pos0 = 128 * j; my_nt = 2 * j + 1 + (w >> 2); }
            else { qrow0 = TP + b * 64; kvrow0 = TP + b * 1088; ntiles = 17; pos0 = 1024; wq = w & 3; wactive = w < 4; my_nt = wactive ? 17 : 0; }
        } else {
            int bg; h = it & 3; ntiles = 4;
            if (it < 1024) { bg = it >> 6; qrow0 = bg * 2048 + ((it >> 2) & 15) * 128; }
            else { const int b = (it - 1024) >> 2; bg = 16 + b; qrow0 = TP + b * 64; wq = w & 3; wactive = w < 4; }
            my_nt = 4;
            kbase = kxb + (size_t)bg * 262144 + h * 256; vbase = vxt + (size_t)(bg * 4 + h) * 65536;
        }
        bf16x8 qf[NKS];
        { const bf16_t* qp = Q + (size_t)(qrow0 + 16 * wq + fr) * LDQ + h * DQK + 8 * fq;
#pragma unroll
          for (int k = 0; k < NKS; ++k) qf[k] = *(const bf16x8*)(qp + 32 * k); }
        if (MODE == 0) {
            const float pos = (float)(pos0 + 16 * wq + fr); float y[8];
#pragma unroll
            for (int j = 0; j < 8; ++j) { const float x = bf2f((unsigned short)qf[2][j]), xp = lane_xor32(x, fq); float cs, sn; cis_turns(pos * rope_ift(8 * (fq & 1) + j), cs, sn);
                y[j] = (fq < 2) ? x * cs - xp * sn : xp * sn + x * cs; }
#pragma unroll
            for (int j = 0; j < 8; j += 2) { const unsigned pw = pk2(y[j], y[j + 1]); qf[2][j] = (short)(pw & 0xffffu); qf[2][j + 1] = (short)(pw >> 16); }
        }
        f32x4 ot[NDW];
#pragma unroll
        for (int d = 0; d < NDW; ++d) ot[d] = (f32x4){0.f, 0.f, 0.f, 0.f};
        float mrun = -1e30f, lrun = 0.f;
        u32x4 kr[NKR], vr[NVR];
#define ATT_LD(kt_) do { \
        if (MODE == 0) { \
            _Pragma("unroll") for (int r = 0; r < 2; ++r) { const int q = th + 512 * r; if (q < 768) { const int key = q / 12, pc = q % 12; const size_t krow = (size_t)(kvrow0 + 64 * (kt_) + key); \
                kr[r] = *(const u32x4*)(pc < 8 ? kvb + krow * 1024 + h * 128 + 8 * pc : krb + krow * 32 + 8 * (pc - 8)); } } \
            { const int key = th & 63, pc = th >> 6; const size_t krow = (size_t)(kvrow0 + 64 * (kt_) + key); \
                vr[0] = *(const u32x4*)(kvb + krow * 1024 + h * 128 + 64 + 8 * pc); } \
        } else { \
            _Pragma("unroll") for (int r = 0; r < 4; ++r) { const int q = th + 512 * r; kr[r] = *(const u32x4*)(kbase + (size_t)(64 * (kt_) + (q >> 5)) * 1024 + 8 * (q & 31)); \
                vr[r] = *(const u32x4*)(vbase + (size_t)(q >> 3) * 256 + 64 * (kt_) + 8 * (q & 7)); } \
        } } while (0)
        ATT_LD(0);
        for (int kt = 0; kt < ntiles; ++kt) {
            __syncthreads();
            if (MODE == 0) {
#pragma unroll
                for (int r = 0; r < 2; ++r) { const int q = th + 512 * r; if (q < 768) { const int key = q / 12, pc = q % 12; *(LAS u32x4*)(Ks + key * KSTR + 8 * pc) = kr[r]; } }
                { const int key = th & 63, pc = th >> 6; const u32x4 v = vr[0]; LAS bf16_t* d = Vt + (8 * pc) * VSTR + key;
                    d[0] = (bf16_t)(v.x & 0xffffu); d[VSTR] = (bf16_t)(v.x >> 16); d[2 * VSTR] = (bf16_t)(v.y & 0xffffu); d[3 * VSTR] = (bf16_t)(v.y >> 16);
                    d[4 * VSTR] = (bf16_t)(v.z & 0xffffu); d[5 * VSTR] = (bf16_t)(v.z >> 16); d[6 * VSTR] = (bf16_t)(v.w & 0xffffu); d[7 * VSTR] = (bf16_t)(v.w >> 16); }
            } else {
#pragma unroll
                for (int r = 0; r < 4; ++r) { const int q = th + 512 * r; *(LAS u32x4*)(Ks + (q >> 5) * KSTR + 8 * (q & 31)) = kr[r]; *(LAS u32x4*)(Vt + (q >> 3) * VSTR + 8 * (q & 7)) = vr[r]; }
            }
            __syncthreads();
            if (kt + 1 < ntiles) ATT_LD(kt + 1);
            if (kt < my_nt) {
            f32x4 st[4];
#pragma unroll
            for (int nb = 0; nb < 4; ++nb) { st[nb] = (f32x4){0.f, 0.f, 0.f, 0.f};
#pragma unroll
                for (int k = 0; k < NKS; ++k) { const bf16x8 a = *(const LAS bf16x8*)(Ks + (16 * nb + fr) * KSTR + 32 * k + 8 * fq); st[nb] = __builtin_amdgcn_mfma_f32_16x16x32_bf16(a, qf[k], st[nb], 0, 0, 0); } }
            float mx = -1e30f;
#pragma unroll
            for (int nb = 0; nb < 4; ++nb) mx = fmaxf(mx, fmaxf(fmaxf(st[nb].x, st[nb].y), fmaxf(st[nb].z, st[nb].w)));
            mx = red_max32(red_max16(mx));
            const float mnew = fmaxf(mrun, mx), alpha = __builtin_amdgcn_exp2f(mrun - mnew); mrun = mnew;
            float lsum = 0.f;
#pragma unroll
            for (int nb = 0; nb < 4; ++nb)
#pragma unroll
                for (int j = 0; j < 4; ++j) { const float p = __builtin_amdgcn_exp2f(st[nb][j] - mnew); st[nb][j] = p; lsum += p; }
            lrun = lrun * alpha + lsum;
#pragma unroll
            for (int d = 0; d < NDW; ++d) ot[d] = ot[d] * alpha;
#pragma unroll
            for (int k2 = 0; k2 < 2; ++k2) {
                bf16x8 pb; { const unsigned w0 = pk2(st[2 * k2].x, st[2 * k2].y), w1 = pk2(st[2 * k2].z, st[2 * k2].w), w2 = pk2(st[2 * k2 + 1].x, st[2 * k2 + 1].y), w3 = pk2(st[2 * k2 + 1].z, st[2 * k2 + 1].w);
                    pb[0] = (short)(w0 & 0xffffu); pb[1] = (short)(w0 >> 16); pb[2] = (short)(w1 & 0xffffu); pb[3] = (short)(w1 >> 16); pb[4] = (short)(w2 & 0xffffu); pb[5] = (short)(w2 >> 16); pb[6] = (short)(w3 & 0xffffu); pb[7] = (short)(w3 >> 16); }
#pragma unroll
                for (int d = 0; d < NDW; ++d) { const LAS bf16_t* vp_ = Vt + (16 * d + fr) * VSTR + 32 * k2 + 4 * fq;
                    const bf16x4 lo = *(const LAS bf16x4*)vp_, hi = *(const LAS bf16x4*)(vp_ + 16);
                    bf16x8 a; a[0] = lo[0]; a[1] = lo[1]; a[2] = lo[2]; a[3] = lo[3]; a[4] = hi[0]; a[5] = hi[1]; a[6] = hi[2]; a[7] = hi[3];
                    ot[d] = __builtin_amdgcn_mfma_f32_16x16x32_bf16(a, pb, ot[d], 0, 0, 0); }
            }
            }
        }
#undef ATT_LD
        const float lt = red_sum32(red_sum16(lrun)); const float inv = 1.0f / lt;
        bf16_t* op = O + (size_t)(qrow0 + 16 * wq + fr) * 1024 + h * DV + 4 * fq;
        if (wactive) {
#pragma unroll
            for (int d = 0; d < NDW; ++d) { u32x2 o; o.x = pk2(ot[d].x * inv, ot[d].y * inv); o.y = pk2(ot[d].z * inv, ot[d].w * inv); *(u32x2*)(op + 16 * d) = o; }
        }
    }
}

__device__ __forceinline__ void tr_loop(const float* W, int K, int N, const float* gain, bf16_t* WT, int row_off, int mode, LAS float* scr, int gw, int ngw, int lane) {
    const int nblk = N / 32, nitems = (K / 64) * nblk, half = N >> 1;
    for (int item = gw; item < nitems; item += ngw) {
        const int kb = item / nblk, nb = item % nblk, k0 = 64 * kb, n0 = 32 * nb;
#pragma unroll 8
        for (int i = 0; i < 32; ++i) { const int kk = 2 * i + (lane >> 5); float v = W[(size_t)(k0 + kk) * N + n0 + (lane & 31)]; if (gain) v *= gain[k0 + kk]; scr[kk * 33 + (lane & 31)] = v; }
        asm volatile("s_waitcnt lgkmcnt(0)" ::: "memory");
        const int c = lane & 7;
#pragma unroll
        for (int j = 0; j < 4; ++j) { const int n = (lane >> 3) + 8 * j; const LAS float* s = scr + (8 * c) * 33 + n;
            u32x4 o; o.x = pk2(s[0], s[33]); o.y = pk2(s[66], s[99]); o.z = pk2(s[132], s[165]); o.w = pk2(s[198], s[231]);
            const int col = n0 + n; int row;
            if (mode == 0) row = row_off + col; else { const int hs = col >= half ? 1 : 0, cc = col - hs * half; row = (cc >> 7) * 256 + hs * 128 + (cc & 127); }
            *(u32x4*)(WT + (size_t)row * K + k0 + 8 * c) = o; }
        asm volatile("s_waitcnt lgkmcnt(0)" ::: "memory");
    }
}

constexpr int LDS_BYTES = 2 * (64 * 264 * 2 + 256 * 72 * 2);
struct Args { const float* in[41]; float* out; unsigned char* ws; int ph_lo, ph_hi; };

__device__ __forceinline__ void tr_weight_job(const Args& a, unsigned char* ws, int j, LAS float* scr, int gw, int ngw, int lane) {
                const float* W; const float* gain = nullptr; bf16_t* WT; int K, N, mode = 0, roff = 0;
                switch (j) {
                    case 0: W = a.in[11]; gain = a.in[10]; WT = (bf16_t*)(ws + W_GU_A); K = 1024; N = 5632; mode = 1; break;
                    case 1: W = a.in[12]; WT = (bf16_t*)(ws + W_DN_A); K = 2816; N = 1024; break;
                    case 2: W = a.in[38]; gain = a.in[37]; WT = (bf16_t*)(ws + W_GU_B); K = 1024; N = 5632; mode = 1; break;
                    case 3: W = a.in[39]; WT = (bf16_t*)(ws + W_DN_B); K = 2816; N = 1024; break;
                    case 4: W = a.in[14]; gain = a.in[13]; WT = (bf16_t*)(ws + W_INE); K = 1024; N = 2080; break;
                    case 5: W = a.in[17]; WT = (bf16_t*)(ws + W_UQ); K = 256; N = 768; break;
                    case 6: W = a.in[18]; WT = (bf16_t*)(ws + W_UKV); K = 256; N = 1024; break;
                    case 7: W = a.in[20]; WT = (bf16_t*)(ws + W_OUT); K = 1024; N = 1024; break;
                    case 8: W = a.in[21]; gain = a.in[13] + 1024; WT = (bf16_t*)(ws + W_INO); K = 1024; N = 1024; break;
                    case 9: W = a.in[30]; WT = (bf16_t*)(ws + W_GLU); K = 1024; N = 2048; mode = 1; break;
                    case 10: W = a.in[33]; gain = a.in[31]; WT = (bf16_t*)(ws + W_XQ); K = 1024; N = 1024; break;
                    case 11: W = a.in[33] + 1048576; gain = a.in[31] + 1024; WT = (bf16_t*)(ws + W_XQ) + 1048576; K = 1024; N = 1024; break;
                    case 12: W = a.in[36]; WT = (bf16_t*)(ws + W_XO); K = 1024; N = 1024; break;
                    case 13: W = a.in[36] + 1048576; WT = (bf16_t*)(ws + W_XO) + 1048576; K = 1024; N = 1024; break;
                    case 14: W = a.in[34]; gain = a.in[32]; WT = (bf16_t*)(ws + W_MEM); K = 1024; N = 1024; roff = 0; break;
                    case 15: W = a.in[35]; gain = a.in[32]; WT = (bf16_t*)(ws + W_MEM); K = 1024; N = 1024; roff = 1024; break;
                    case 16: W = a.in[34] + 1048576; gain = a.in[32] + 1024; WT = (bf16_t*)(ws + W_MEM); K = 1024; N = 1024; roff = 2048; break;
                    default: W = a.in[35] + 1048576; gain = a.in[32] + 1024; WT = (bf16_t*)(ws + W_MEM); K = 1024; N = 1024; roff = 3072; break;
                }
                tr_loop(W, K, N, gain, WT, roff, mode, scr, gw, ngw, lane);
}

template <int ph, bool SECOND = false>
__device__ __forceinline__ void run_phase(const Args& a, LAS unsigned char* lds, const XcdBarrier& xbar) {
    constexpr float RMUL = SECOND ? 0.0f : 1.0f;
    const int tid = threadIdx.x, lane = tid & 63, wid = __builtin_amdgcn_readfirstlane(tid >> 6);
    const int gw = blockIdx.x * 8 + wid, ngw = gridDim.x * 8, gt = blockIdx.x * 512 + tid, ngt = gridDim.x * 512;
    unsigned char* ws = a.ws; float* out = a.out;
    bf16_t* xb = (bf16_t*)(ws + XB); float* ss = (float*)(ws + SS);
    LAS float* scr = (LAS float*)(lds + wid * 8448);
    const bool fastffn = (gridDim.x == 256);
    const int nbusy = 544 % (int)gridDim.x, tailb = (int)blockIdx.x - nbusy, gwt = tailb * 8 + wid, ngwt = ((int)gridDim.x - nbusy) * 8, gtt = tailb * 512 + tid, ngtt = ((int)gridDim.x - nbusy) * 512;

    {
        constexpr int layer = (ph >= 13 && ph != 26) ? 1 : 0;
        switch (ph) {
        case 0: if (PH_ON(0)) {
            for (int j = 0; j < 18; ++j) if (j < 2 || j >= 14) tr_weight_job(a, ws, j, scr, gw, ngw, lane);
            for (int row0 = gw; row0 < T; row0 += 4 * ngw) {
                f32x4 v[4][4]; bool ok[4];
#pragma unroll
                for (int q = 0; q < 4; ++q) { const int row = row0 + q * ngw; ok[q] = row < T; const int rr = ok[q] ? row : gw;
                    const float* src = rr < TP ? a.in[0] + (size_t)rr * DM : a.in[1] + (size_t)(rr - TP) * DM;
#pragma unroll
                    for (int j = 0; j < 4; ++j) v[q][j] = *(const f32x4*)(src + 4 * lane + 256 * j); }
#pragma unroll
                for (int q = 0; q < 4; ++q) { const int row = row0 + q * ngw; float s = 0.f;
#pragma unroll
                    for (int j = 0; j < 4; ++j) { const f32x4 w = v[q][j]; s += (w.x * w.x + w.y * w.y) + (w.z * w.z + w.w * w.w);
                        if (ok[q]) { u32x2 o; o.x = pk2(w.x, w.y); o.y = pk2(w.z, w.w); *(u32x2*)(xb + (size_t)row * DM + 4 * lane + 256 * j) = o; } }
                    s = wave_sum(s); if (ok[q] && lane < 16) ss[(size_t)row * 32 + lane] = lane == 0 ? s : 0.f; }
            }
            { bf16_t* memb = (bf16_t*)(ws + MEMB); float* ssm = (float*)(ws + SSMEM);
              for (int row = gw; row < 4096; row += ngw) { const float* src = a.in[9] + (size_t)row * DM; float s = 0.f;
#pragma unroll
                for (int j = 0; j < 4; ++j) { const f32x4 v = *(const f32x4*)(src + 4 * lane + 256 * j);
                    u32x2 o; o.x = pk2(v.x, v.y); o.y = pk2(v.z, v.w); *(u32x2*)(memb + (size_t)row * DM + 4 * lane + 256 * j) = o; s += (v.x * v.x + v.y * v.y) + (v.z * v.z + v.w * v.w); }
                s = wave_sum(s); if (lane < 16) ssm[(size_t)row * 32 + lane] = lane == 0 ? s : 0.f; } }
            { bf16_t* latall = (bf16_t*)(ws + LATALL); bf16_t* krb = (bf16_t*)(ws + KRB);
              for (int r0 = gw; r0 < 32 * 1024; r0 += 4 * ngw) {
                f32x4 v[4];
#pragma unroll
                for (int q = 0; q < 4; ++q) { const int r = min(r0 + q * ngw, 32 * 1024 - 1); v[q] = *(const f32x4*)(a.in[2] + (size_t)r * 256 + 4 * lane); }
#pragma unroll
                for (int q = 0; q < 4; ++q) { const int r = r0 + q * ngw; if (r < 32 * 1024) { const int b = r >> 10, s = r & 1023;
                    u32x2 o; o.x = pk2(v[q].x, v[q].y); o.y = pk2(v[q].z, v[q].w); *(u32x2*)(latall + (size_t)(TP + b * 1088 + s) * 256 + 4 * lane) = o; } } }
              for (int i = gt; i < 32 * 1024 * 8; i += ngt) { const int r = i >> 3, pc = i & 7, b = r >> 10, s = r & 1023; const f32x4 v = *(const f32x4*)(a.in[3] + (size_t)r * 32 + 4 * pc);
                u32x2 o; o.x = pk2(v.x, v.y); o.y = pk2(v.z, v.w); *(u32x2*)(krb + (size_t)(TP + b * 1088 + s) * 32 + 4 * pc) = o; } }
        } break;
        case 1: case 11: case 13: case 23: if (PH_ON(1)) {
            const bool second = (ph == 11 || ph == 23);
            if (ph == 1) {
                pg8::Gemm g{(const bf16_t*)(ws + MEMB), (const bf16_t*)(ws + W_MEM), 1024, 1024, 1024, 16, 16, 1, 0, 0};
                pg8::EpiMemKV E{out, (const float*)(ws + SSMEM)}; pg8::gemm_phase(lds, g, E);
            }
            if (fastffn) {
                pg8::EpiSwiglu E{(bf16_t*)(ws + HBUF), ss, 16};
                { pg8::Gemm g{xb, (const bf16_t*)(ws + (second ? W_GU_B : W_GU_A)), 1024, 1024, 1024, 136, 22, 1, 0, 0, 0, 0, 1}; pg8::gemm_phase(lds, g, E); }
                xcd_barrier(xbar);
                { pg8::Gemm g{xb, (const bf16_t*)(ws + (second ? W_GU_B : W_GU_A)), 1024, 1024, 1024, 136, 22, 1, 0, 0, 0, 0, 2}; pg8::gemm_phase(lds, g, E); }
                { pg8::Gemm g{(const bf16_t*)(ws + HBUF), (const bf16_t*)(ws + (second ? W_DN_B : W_DN_A)), FF, FF, FF, 136, 4, 1, 0, 0, 0, 0, 3};
                  pg8::EpiResid Ed{xb, ss, 0.5f * RMUL}; pg8::gemm_phase(lds, g, Ed); }
            } else {
                pg8::Gemm g{xb, (const bf16_t*)(ws + (second ? W_GU_B : W_GU_A)), 1024, 1024, 1024, 136, 22, 1, 0, 0};
                pg8::EpiSwiglu E{(bf16_t*)(ws + HBUF), ss, 16}; pg8::gemm_phase(lds, g, E);
            }
        } break;
        case 2: case 12: case 14: case 24: if (PH_ON(2)) {
            const bool second = (ph == 12 || ph == 24);
            pg8::Gemm g{(const bf16_t*)(ws + HBUF), (const bf16_t*)(ws + (second ? W_DN_B : W_DN_A)), FF, FF, FF, fastffn ? 128 : 136, 4, 1, 0, 0};
            pg8::EpiResid E{xb, ss, 0.5f * RMUL}; pg8::gemm_phase(lds, g, E);
            const bool dojobs = fastffn || tailb >= 0; const int jw = fastffn ? gw : gwt, jnw = fastffn ? ngw : ngwt, jt = fastffn ? gt : gtt, jnt = fastffn ? ngt : ngtt;
            if (ph == 2 && !SECOND && dojobs) {
                __syncthreads();
                tr_weight_job(a, ws, 4, scr, jw, jnw, lane); tr_weight_job(a, ws, 5, scr, jw, jnw, lane); tr_weight_job(a, ws, 6, scr, jw, jnw, lane); tr_weight_job(a, ws, 7, scr, jw, jnw, lane);
            }
        } break;
        case 3: if (PH_ON(3)) {
            pg8::Gemm g{xb, (const bf16_t*)(ws + W_INE), 1024, 1024, 1024, 136, 9, 1, 0, 0};
            pg8::EpiBf<true> E{(bf16_t*)(ws + EVB), EV_LD, ss, 16, 1.0f}; pg8::gemm_phase(lds, g, E);
        } break;
        case 4: if (PH_ON(4)) {
            const bf16_t* evb = (const bf16_t*)(ws + EVB); bf16_t* cqn = (bf16_t*)(ws + CQN); bf16_t* latall = (bf16_t*)(ws + LATALL); bf16_t* krb = (bf16_t*)(ws + KRB); bf16_t* mixcat = (bf16_t*)(ws + MIXCAT);
            const float* qn = a.in[15]; const float* kvn = a.in[16]; const float* cw = a.in[19];
            for (int t = gw; t < T; t += ngw) {
                const bf16_t* ev = evb + (size_t)t * EV_LD; int s, S, kvrow; float pos; float* lat_o; float* kr_o; float* cv_o; const float* past = nullptr;
                if (t < TP) { const int b = t >> 11; s = t & 2047; S = 2048; pos = (float)s; kvrow = t; lat_o = out + O_LATP + (size_t)t * 256; kr_o = out + O_KRP + (size_t)t * 32; cv_o = out + O_CONVP + b * 1024; }
                else { const int ts = t - TP, b = ts >> 6; s = ts & 63; S = 64; pos = (float)(1024 + s); kvrow = TP + b * 1088 + 1024 + s; lat_o = out + O_LATS + (size_t)ts * 256; kr_o = out + O_KRS + (size_t)ts * 32; cv_o = out + O_CONVS + b * 1024; past = a.in[4] + b * 1024; }
                const bf16_t* e1 = ev - (s >= 1 ? EV_LD : 0); const bf16_t* e2 = ev - (s >= 2 ? 2 * EV_LD : 0);
                const u32x2 w_cq = *(const u32x2*)(ev + 4 * lane), w_ckv = *(const u32x2*)(ev + 256 + 4 * lane);
                const unsigned short kr1 = ev[512 + (lane & 15)], kr2 = ev[528 + (lane & 15)];
                const u32x4 gc0 = *(const u32x4*)(ev + 1056 + 8 * lane), vi0 = *(const u32x4*)(ev + 1568 + 8 * lane), gb0 = *(const u32x4*)(ev + 544 + 8 * lane);
                const u32x4 gc1 = *(const u32x4*)(e1 + 1056 + 8 * lane), vi1 = *(const u32x4*)(e1 + 1568 + 8 * lane), gc2 = *(const u32x4*)(e2 + 1056 + 8 * lane), vi2 = *(const u32x4*)(e2 + 1568 + 8 * lane);
                const f32x4 gq = *(const f32x4*)(qn + 4 * lane), gk = *(const f32x4*)(kvn + 4 * lane);
                const f32x4 cw0a = *(const f32x4*)(cw + 8 * lane), cw0b = *(const f32x4*)(cw + 8 * lane + 4), cw1a = *(const f32x4*)(cw + 512 + 8 * lane), cw1b = *(const f32x4*)(cw + 512 + 8 * lane + 4), cw2a = *(const f32x4*)(cw + 1024 + 8 * lane), cw2b = *(const f32x4*)(cw + 1024 + 8 * lane + 4);
                { const u32x2 w = w_cq; const float c0 = bf_lo(w.x), c1 = bf_hi(w.x), c2 = bf_lo(w.y), c3 = bf_hi(w.y);
                  const float rs = rsqrtf(wave_sum((c0 * c0 + c1 * c1) + (c2 * c2 + c3 * c3)) * (1.0f / 256.0f) + EPS);
                  u32x2 o; o.x = pk2(c0 * rs * gq.x, c1 * rs * gq.y); o.y = pk2(c2 * rs * gq.z, c3 * rs * gq.w); *(u32x2*)(cqn + (size_t)t * 256 + 4 * lane) = o; }
                { const u32x2 w = w_ckv; const float c0 = bf_lo(w.x), c1 = bf_hi(w.x), c2 = bf_lo(w.y), c3 = bf_hi(w.y);
                  const float rs = rsqrtf(wave_sum((c0 * c0 + c1 * c1) + (c2 * c2 + c3 * c3)) * (1.0f / 256.0f) + EPS);
                  f32x4 lv; lv.x = c0 * rs * gk.x; lv.y = c1 * rs * gk.y; lv.z = c2 * rs * gk.z; lv.w = c3 * rs * gk.w; *(f32x4*)(lat_o + 4 * lane) = lv;
                  u32x2 o; o.x = pk2(lv.x, lv.y); o.y = pk2(lv.z, lv.w); *(u32x2*)(latall + (size_t)kvrow * 256 + 4 * lane) = o; }
                if (lane < 16) { const float x1 = bf2f(kr1), x2 = bf2f(kr2); float cs, sn; cis_turns(pos * rope_ift(lane), cs, sn);
                  const float o1 = x1 * cs - x2 * sn, o2 = x1 * sn + x2 * cs; kr_o[lane] = o1; kr_o[16 + lane] = o2; krb[(size_t)kvrow * 32 + lane] = f2bf(o1); krb[(size_t)kvrow * 32 + 16 + lane] = f2bf(o2); }
                {
                    float u0[8], u1[8], u2[8], gb[8];
                    { const u32x4 gc = gc0, vi = vi0, g_ = gb0;
                      u0[0] = bf_lo(gc.x) * bf_lo(vi.x); u0[1] = bf_hi(gc.x) * bf_hi(vi.x); u0[2] = bf_lo(gc.y) * bf_lo(vi.y); u0[3] = bf_hi(gc.y) * bf_hi(vi.y);
                      u0[4] = bf_lo(gc.z) * bf_lo(vi.z); u0[5] = bf_hi(gc.z) * bf_hi(vi.z); u0[6] = bf_lo(gc.w) * bf_lo(vi.w); u0[7] = bf_hi(gc.w) * bf_hi(vi.w);
                      gb[0] = bf_lo(g_.x); gb[1] = bf_hi(g_.x); gb[2] = bf_lo(g_.y); gb[3] = bf_hi(g_.y); gb[4] = bf_lo(g_.z); gb[5] = bf_hi(g_.z); gb[6] = bf_lo(g_.w); gb[7] = bf_hi(g_.w); }
                    if (s >= 1) { const u32x4 gc = gc1, vi = vi1;
                      u1[0] = bf_lo(gc.x) * bf_lo(vi.x); u1[1] = bf_hi(gc.x) * bf_hi(vi.x); u1[2] = bf_lo(gc.y) * bf_lo(vi.y); u1[3] = bf_hi(gc.y) * bf_hi(vi.y);
                      u1[4] = bf_lo(gc.z) * bf_lo(vi.z); u1[5] = bf_hi(gc.z) * bf_hi(vi.z); u1[6] = bf_lo(gc.w) * bf_lo(vi.w); u1[7] = bf_hi(gc.w) * bf_hi(vi.w); }
                    else if (past) { const f32x4 p0 = *(const f32x4*)(past + 512 + 8 * lane), p1 = *(const f32x4*)(past + 512 + 8 * lane + 4); u1[0] = p0.x; u1[1] = p0.y; u1[2] = p0.z; u1[3] = p0.w; u1[4] = p1.x; u1[5] = p1.y; u1[6] = p1.z; u1[7] = p1.w; }
                    else {
#pragma unroll
                        for (int j = 0; j < 8; ++j) u1[j] = 0.f; }
                    if (s >= 2) { const u32x4 gc = gc2, vi = vi2;
                      u2[0] = bf_lo(gc.x) * bf_lo(vi.x); u2[1] = bf_hi(gc.x) * bf_hi(vi.x); u2[2] = bf_lo(gc.y) * bf_lo(vi.y); u2[3] = bf_hi(gc.y) * bf_hi(vi.y);
                      u2[4] = bf_lo(gc.z) * bf_lo(vi.z); u2[5] = bf_hi(gc.z) * bf_hi(vi.z); u2[6] = bf_lo(gc.w) * bf_lo(vi.w); u2[7] = bf_hi(gc.w) * bf_hi(vi.w); }
                    else if (past) { const float* pp = past + s * 512 + 8 * lane; const f32x4 p0 = *(const f32x4*)pp, p1 = *(const f32x4*)(pp + 4); u2[0] = p0.x; u2[1] = p0.y; u2[2] = p0.z; u2[3] = p0.w; u2[4] = p1.x; u2[5] = p1.y; u2[6] = p1.z; u2[7] = p1.w; }
                    else {
#pragma unroll
                        for (int j = 0; j < 8; ++j) u2[j] = 0.f; }
                    float z[8];
#pragma unroll
                    for (int j = 0; j < 8; ++j) { const float k0 = j < 4 ? cw0a[j & 3] : cw0b[j & 3], k1 = j < 4 ? cw1a[j & 3] : cw1b[j & 3], k2 = j < 4 ? cw2a[j & 3] : cw2b[j & 3]; z[j] = gb[j] * (k0 * u2[j] + k1 * u1[j] + k2 * u0[j]); }
                    u32x4 o; o.x = pk2(z[0], z[1]); o.y = pk2(z[2], z[3]); o.z = pk2(z[4], z[5]); o.w = pk2(z[6], z[7]); *(u32x4*)(mixcat + (size_t)t * DM + 512 + 8 * lane) = o;
                    if (s >= S - 2) { float* cp_ = cv_o + (s - (S - 2)) * 512 + 8 * lane; *(f32x4*)cp_ = (f32x4){u0[0], u0[1], u0[2], u0[3]}; *(f32x4*)(cp_ + 4) = (f32x4){u0[4], u0[5], u0[6], u0[7]}; }
                }
            }
        } break;
        case 5: if (PH_ON(5)) {
            { pg8::Gemm g{(const bf16_t*)(ws + CQN), (const bf16_t*)(ws + W_UQ), 256, 256, 256, 136, 3, 1, 0, 0};
              pg8::EpiBf<false> E{(bf16_t*)(ws + QB), 768, nullptr, 16, 1.44269504f * 0.10206207f}; pg8::gemm_phase(lds, g, E); }
            { pg8::Gemm g{(const bf16_t*)(ws + LATALL), (const bf16_t*)(ws + W_UKV), 256, 256, 256, 264, 4, 1, 0, 0, 0, 0, 0, 104};
              pg8::EpiBf<false> E{(bf16_t*)(ws + KVB), 1024, nullptr, 16, 1.0f}; pg8::gemm_phase(lds, g, E); }
        } break;
        case 6: if (PH_ON(6)) {
            attn_phase<0>(lds, (const bf16_t*)(ws + QB), (const bf16_t*)(ws + KVB), (const bf16_t*)(ws + KRB), nullptr, nullptr, (bf16_t*)(ws + MIXCAT));
        } break;
        case 7: if (PH_ON(7)) {
            pg8::Gemm g{(const bf16_t*)(ws + MIXCAT), (const bf16_t*)(ws + W_OUT), 1024, 1024, 1024, 136, 4, 1, 0, 0};
            pg8::EpiResid E{xb, ss, 1.0f * RMUL}; pg8::gemm_phase(lds, g, E);
            if (!SECOND && tailb >= 0) {
                __syncthreads();
                if (!fastffn) {
                tr_loop(a.in[11] + (size_t)1024 * 5632, 1024, 5632, a.in[10] + 1024, (bf16_t*)(ws + W_GU_A), 0, 1, scr, gwt, ngwt, lane);
                tr_loop(a.in[12] + (size_t)2816 * 1024, 2816, 1024, nullptr, (bf16_t*)(ws + W_DN_A), 0, 0, scr, gwt, ngwt, lane);
                } else {
                for (int j = 2; j < 14; ++j) if (j < 4 || j >= 8) tr_weight_job(a, ws, j, scr, gwt, ngwt, lane);
            {
                float* klag = (float*)(ws + KLAG);
                for (int idx = gtt; idx < 65536; idx += ngtt) { const int g = idx >> 10, d = (idx >> 4) & 63, cp = idx & 15; const float dt = __expf(a.in[28][g]);
                    float accv[16];
#pragma unroll
                    for (int c = 0; c < 16; ++c) accv[c] = 0.f;
                    for (int p = 0; p < 64; ++p) { const float are = a.in[22][g * 64 + p], aim = a.in[23][g * 64 + p]; float abr, abi; cpow(are, aim, dt, 1.f, abr, abi);
                        const float nr = abr - 1.f, ni = abi, den = 1.0f / (are * are + aim * aim), fr_ = (nr * are + ni * aim) * den, fi = (ni * are - nr * aim) * den;
                        const float bre = a.in[24][(g * 64 + p) * 16 + cp], bim = a.in[25][(g * 64 + p) * 16 + cp], bbr = fr_ * bre - fi * bim, bbi = fr_ * bim + fi * bre;
                        float pr, pi; cpow(are, aim, dt, (float)d, pr, pi); const float wr_ = pr * bbr - pi * bbi, wi = pr * bbi + pi * bbr;
#pragma unroll
                        for (int c = 0; c < 16; ++c) accv[c] += a.in[26][(g * 16 + c) * 64 + p] * wr_ - a.in[27][(g * 16 + c) * 64 + p] * wi; }
#pragma unroll
                    for (int c = 0; c < 16; ++c) klag[((size_t)(g * 64 + d) * 16 + c) * 16 + cp] = accv[c]; }
            }
                }
            }
        } break;
        case 8: case 20: if (PH_ON(8)) {
            pg8::Gemm g{xb, (const bf16_t*)(ws + W_XQ) + (size_t)layer * 1048576, 1024, 1024, 1024, 136, 4, 1, 0, 0};
            pg8::EpiBf<true> E{(bf16_t*)(ws + QX), 1024, ss, ph == 20 ? 32 : 16, 0.0625f * 1.44269504f}; pg8::gemm_phase(lds, g, E);
            if (!SECOND && tailb >= 0) {
                __syncthreads();
                bf16_t* kx = (bf16_t*)(ws + KXB); bf16_t* vx = (bf16_t*)(ws + VXT);
                for (int bg = 0; bg < 48; ++bg) { const float* vsrc = bg < 16 ? out + O_MVP + (size_t)layer * 4194304 + (size_t)bg * 262144 : a.in[8] + (size_t)layer * 8388608 + (size_t)(bg - 16) * 262144;
                    tr_loop(vsrc, 256, 1024, nullptr, vx + (size_t)bg * 262144, 0, 0, scr, gwt, ngwt, lane); }
                for (int i = gtt; i < 48 * 32768; i += ngtt) { const int bg = i >> 15, e = (i & 32767) * 8;
                    const float* ksrc = (bg < 16 ? out + O_MKP + (size_t)layer * 4194304 + (size_t)bg * 262144 : a.in[7] + (size_t)layer * 8388608 + (size_t)(bg - 16) * 262144) + e;
                    const f32x4 v0 = *(const f32x4*)ksrc, v1 = *(const f32x4*)(ksrc + 4); u32x4 o; o.x = pk2(v0.x, v0.y); o.y = pk2(v0.z, v0.w); o.z = pk2(v1.x, v1.y); o.w = pk2(v1.z, v1.w);
                    *(u32x4*)(kx + (size_t)bg * 262144 + e) = o; }
            }
        } break;
        case 9: case 21: if (PH_ON(9)) {
            attn_phase<1>(lds, (const bf16_t*)(ws + QX), nullptr, nullptr, (const bf16_t*)(ws + KXB), (const bf16_t*)(ws + VXT), (bf16_t*)(ws + ATTX));
        } break;
        case 10: case 22: if (PH_ON(10)) {
            pg8::Gemm g{(const bf16_t*)(ws + ATTX), (const bf16_t*)(ws + W_XO) + (size_t)layer * 1048576, 1024, 1024, 1024, 136, 4, 1, 0, 0};
            pg8::EpiResid E{xb, ss, 1.0f * RMUL}; pg8::gemm_phase(lds, g, E);
            if (fastffn && !SECOND && tailb >= 0) {
                __syncthreads();
                if (ph == 10) {
                tr_loop(a.in[11] + (size_t)1024 * 5632, 1024, 5632, a.in[10] + 1024, (bf16_t*)(ws + W_GU_A), 0, 1, scr, gwt, ngwt, lane);
                tr_loop(a.in[12] + (size_t)2816 * 1024, 2816, 1024, nullptr, (bf16_t*)(ws + W_DN_A), 0, 0, scr, gwt, ngwt, lane);
                bf16_t* bte = (bf16_t*)(ws + BTE);
                for (int idx = gtt; idx < 262144; idx += ngtt) { const int g = idx >> 12, p = (idx >> 6) & 63, j = idx & 63; const float dt = __expf(a.in[28][g]);
                    const float are = a.in[22][g * 64 + p], aim = a.in[23][g * 64 + p]; float abr, abi; cpow(are, aim, dt, 1.f, abr, abi);
                    const float nr = abr - 1.f, ni = abi, den = 1.0f / (are * are + aim * aim), fr_ = (nr * are + ni * aim) * den, fi = (ni * are - nr * aim) * den;
                    float pr, pi; cpow(are, aim, dt, (float)(63 - j), pr, pi); const float wr_ = pr * fr_ - pi * fi, wi = pr * fi + pi * fr_;
                    float re[16], im[16];
#pragma unroll
                    for (int c = 0; c < 16; ++c) { const float bre = a.in[24][(g * 64 + p) * 16 + c], bim = a.in[25][(g * 64 + p) * 16 + c]; re[c] = wr_ * bre - wi * bim; im[c] = wr_ * bim + wi * bre; }
                    u32x4 o; bf16_t* d0 = bte + ((size_t)(g * 128 + p) * 1024 + j * 16); bf16_t* d1 = bte + ((size_t)(g * 128 + 64 + p) * 1024 + j * 16);
                    o.x = pk2(re[0], re[1]); o.y = pk2(re[2], re[3]); o.z = pk2(re[4], re[5]); o.w = pk2(re[6], re[7]); *(u32x4*)d0 = o;
                    o.x = pk2(re[8], re[9]); o.y = pk2(re[10], re[11]); o.z = pk2(re[12], re[13]); o.w = pk2(re[14], re[15]); *(u32x4*)(d0 + 8) = o;
                    o.x = pk2(im[0], im[1]); o.y = pk2(im[2], im[3]); o.z = pk2(im[4], im[5]); o.w = pk2(im[6], im[7]); *(u32x4*)d1 = o;
                    o.x = pk2(im[8], im[9]); o.y = pk2(im[10], im[11]); o.z = pk2(im[12], im[13]); o.w = pk2(im[14], im[15]); *(u32x4*)(d1 + 8) = o; }
                } else {
                tr_loop(a.in[38] + (size_t)1024 * 5632, 1024, 5632, a.in[37] + 1024, (bf16_t*)(ws + W_GU_B), 0, 1, scr, gwt, ngwt, lane);
                tr_loop(a.in[39] + (size_t)2816 * 1024, 2816, 1024, nullptr, (bf16_t*)(ws + W_DN_B), 0, 0, scr, gwt, ngwt, lane);
                }
            }
        } break;
        case 15: if (PH_ON(15)) {
            pg8::Gemm g{xb, (const bf16_t*)(ws + W_INO), 1024, 1024, 1024, 136, 4, 1, 0, 0};
            pg8::EpiU E{(bf16_t*)(ws + UPACK), ss, 16}; pg8::gemm_phase(lds, g, E);
            if (fastffn && !SECOND && tailb >= 0) {
                __syncthreads();
                const float* klag = (const float*)(ws + KLAG); bf16_t* bty = (bf16_t*)(ws + BTY);
                for (int r = gwt; r < 65536; r += ngwt) { const int g = r >> 10, n = r & 1023, l = n >> 4, c = n & 15; bf16_t* dst = bty + (size_t)r * UP_LD;
                    u32x4 o0 = {0u, 0u, 0u, 0u}, o1 = {0u, 0u, 0u, 0u};
                    if (lane <= l) { const float* kp_ = klag + ((size_t)(g * 64 + (l - lane)) * 16 + c) * 16; const f32x4 k0 = *(const f32x4*)kp_, k1 = *(const f32x4*)(kp_ + 4), k2 = *(const f32x4*)(kp_ + 8), k3 = *(const f32x4*)(kp_ + 12);
                        o0.x = pk2(k0.x, k0.y); o0.y = pk2(k0.z, k0.w); o0.z = pk2(k1.x, k1.y); o0.w = pk2(k1.z, k1.w); o1.x = pk2(k2.x, k2.y); o1.y = pk2(k2.z, k2.w); o1.z = pk2(k3.x, k3.y); o1.w = pk2(k3.z, k3.w); }
                    if (lane < 16 * ((l >> 4) + 1)) { *(u32x4*)(dst + 128 + lane * 16) = o0; *(u32x4*)(dst + 128 + lane * 16 + 8) = o1; }
                    const float dt = __expf(a.in[28][g]); float pr, pi; cpow(a.in[22][g * 64 + lane], a.in[23][g * 64 + lane], dt, (float)(l + 1), pr, pi);
                    const float cr = a.in[26][(g * 16 + c) * 64 + lane], ci = a.in[27][(g * 16 + c) * 64 + lane];
                    dst[lane] = f2bf(cr * pr - ci * pi); dst[64 + lane] = f2bf(-(cr * pi + ci * pr)); }
            }
        } break;
        case 16: if (PH_ON(16)) {
            pg8::Gemm g{(const bf16_t*)(ws + UPACK) + 128, (const bf16_t*)(ws + BTE), UP_LD, 1024, 1024, 3, 1, 64, (long)NCH * UP_LD, (long)128 * 1024};
            pg8::EpiE E{(float*)(ws + EBUF)}; pg8::gemm_phase(lds, g, E);
        } break;
        case 17: if (PH_ON(17)) {
            const float* eb = (const float*)(ws + EBUF); bf16_t* up = (bf16_t*)(ws + UPACK);
            for (int idx = gt; idx < 48 * 4096; idx += ngt) { const int bg = idx >> 12, g = (idx >> 6) & 63, p = idx & 63; const float dt = __expf(a.in[28][g]);
                float ar, ai; cpow(a.in[22][g * 64 + p], a.in[23][g * 64 + p], dt, 64.f, ar, ai);
                float hr = 0.f, hi = 0.f; int chunk0, n; float* o_re; float* o_im;
                if (bg < 16) { chunk0 = bg * 32; n = 32; o_re = out + O_SREP + (size_t)(bg * 64 + g) * 64 + p; o_im = out + O_SIMP + (size_t)(bg * 64 + g) * 64 + p; }
                else { const int bs = bg - 16; chunk0 = 512 + bs; n = 1; hr = a.in[5][(size_t)(bs * 64 + g) * 64 + p]; hi = a.in[6][(size_t)(bs * 64 + g) * 64 + p]; o_re = out + O_SRES + (size_t)(bs * 64 + g) * 64 + p; o_im = out + O_SIMS + (size_t)(bs * 64 + g) * 64 + p; }
                if (n == 32) {
                    for (int c0 = 0; c0 < 32; c0 += 8) { float er[8], ei[8];
#pragma unroll
                        for (int c = 0; c < 8; ++c) { const size_t r = (size_t)g * NCH + chunk0 + c0 + c; er[c] = eb[r * 128 + p]; ei[c] = eb[r * 128 + 64 + p]; }
#pragma unroll
                        for (int c = 0; c < 8; ++c) { const size_t r = (size_t)g * NCH + chunk0 + c0 + c; up[r * UP_LD + p] = f2bf(hr); up[r * UP_LD + 64 + p] = f2bf(hi);
                            const float nr = ar * hr - ai * hi + er[c], ni = ar * hi + ai * hr + ei[c]; hr = nr; hi = ni; } }
                } else { const size_t r = (size_t)g * NCH + chunk0; up[r * UP_LD + p] = f2bf(hr); up[r * UP_LD + 64 + p] = f2bf(hi);
                    const float er = eb[r * 128 + p], ei = eb[r * 128 + 64 + p]; const float nr = ar * hr - ai * hi + er, ni = ar * hi + ai * hr + ei; hr = nr; hi = ni; }
                *o_re = hr; *o_im = hi; }
        } break;
        case 18: if (PH_ON(18)) {
            pg8::Gemm g{(const bf16_t*)(ws + UPACK), (const bf16_t*)(ws + BTY), UP_LD, UP_LD, UP_LD, 3, 4, 64, (long)NCH * UP_LD, (long)1024 * UP_LD, 1};
            pg8::EpiY E{(bf16_t*)(ws + YBUF), (const bf16_t*)(ws + UPACK), a.in[29]}; pg8::gemm_phase(lds, g, E);
        } break;
        case 19: if (PH_ON(19)) {
            pg8::Gemm g{(const bf16_t*)(ws + YBUF), (const bf16_t*)(ws + W_GLU), 16, 1024, 1024, 136, 8, 1, (long)T * 16, 0, 0, 1};
            pg8::EpiGluResid E{xb, ss, RMUL}; pg8::gemm_phase(lds, g, E);
        } break;
        default: if (PH_ON(25)) {
            const float* gf = a.in[40];
            for (int row0 = gw; row0 < T; row0 += 4 * ngw) {
                u32x2 xw[4][4]; bool ok[4];
#pragma unroll
                for (int q = 0; q < 4; ++q) { const int row = row0 + q * ngw; ok[q] = row < T; const int rr = ok[q] ? row : gw;
#pragma unroll
                    for (int j = 0; j < 4; ++j) xw[q][j] = *(const u32x2*)(xb + (size_t)rr * DM + 4 * lane + 256 * j); }
#pragma unroll
                for (int q = 0; q < 4; ++q) { const int row = row0 + q * ngw; float* p = out + O_Y + (size_t)row * DM; f32x4 v[4]; float s = 0.f;
#pragma unroll
                    for (int j = 0; j < 4; ++j) { const u32x2 w = xw[q][j]; v[j] = (f32x4){bf_lo(w.x), bf_hi(w.x), bf_lo(w.y), bf_hi(w.y)};
                        s += (v[j].x * v[j].x + v[j].y * v[j].y) + (v[j].z * v[j].z + v[j].w * v[j].w); }
                    const float rs = rsqrtf(wave_sum(s) * (1.0f / 1024.0f) + EPS);
                    if (ok[q]) {
#pragma unroll
                        for (int j = 0; j < 4; ++j) { const f32x4 gg = *(const f32x4*)(gf + 4 * lane + 256 * j); *(f32x4*)(p + 4 * lane + 256 * j) = v[j] * rs * gg; } } }
            }
        } break;
        }
    }
}

__global__ void __launch_bounds__(512, 2) mk(Args a) {
    extern __shared__ __attribute__((aligned(16))) unsigned char shm[];
    LAS unsigned char* lds = (LAS unsigned char*)shm;
    const int lo = a.ph_lo, hi = a.ph_hi;
    volatile LAS unsigned* bst = (volatile LAS unsigned*)(lds + LDS_BYTES);
    if (threadIdx.x == 0) { bst[0] = 0u; bst[1] = 0u; bst[2] = 0u; bst[3] = 0u; }
    __syncthreads();
    XcdBarrier xbar; xbar.bar = (unsigned*)(a.ws + WS_BAR); xbar.x = 0; xbar.st = bst;
    if (hi - lo > 1) xbar = xcd_barrier_post((unsigned*)(a.ws + WS_BAR), bst);
    if (lo > 1000) cg::this_grid().sync();
#define STEP(p, k) if (lo <= (p) && (p) < hi) { run_phase<k>(a, lds, xbar); if (((DBLMASK) >> (k)) & 1u) { __syncthreads(); run_phase<k, true>(a, lds, xbar); } } if (lo <= (p) && (p) + 1 < hi) xcd_barrier(xbar);
    STEP(0, 0) STEP(1, 1) STEP(2, 2) STEP(3, 3) STEP(4, 4) STEP(5, 5) STEP(6, 6) STEP(7, 7) STEP(8, 8) STEP(9, 9) STEP(10, 10) STEP(11, 11) STEP(12, 12) STEP(13, 13) STEP(14, 14) STEP(15, 15) STEP(16, 16) STEP(17, 17) STEP(18, 18) STEP(19, 19) STEP(20, 20) STEP(21, 21) STEP(22, 22) STEP(23, 23) STEP(24, 24) STEP(25, 25)
#undef STEP
}


extern "C" void kernel_launch(void* const* d_in, const int* in_sizes, int n_in, void* d_out, int out_size, void* d_ws, size_t ws_size, hipStream_t stream) {
    static int grid = 0;
    if (grid == 0) {
        if (n_in != 41 || (size_t)out_size != O_END || ws_size < WS_END) { fprintf(stderr, "kernel_launch: unexpected shapes: n_in %d out %d ws %zu (need %zu)\n", n_in, out_size, ws_size, (size_t)WS_END); grid = -1; return; }
        int dev = 0, cus = 0, per_cu = 0;
        hipGetDevice(&dev); hipDeviceGetAttribute(&cus, hipDeviceAttributeMultiprocessorCount, dev);
        if (hipFuncSetAttribute((const void*)mk, hipFuncAttributeMaxDynamicSharedMemorySize, LDS_BYTES + 16) != hipSuccess) { fprintf(stderr, "kernel_launch: hipFuncSetAttribute failed\n"); grid = -1; return; }
        if (hipOccupancyMaxActiveBlocksPerMultiprocessor(&per_cu, (const void*)mk, 512, LDS_BYTES + 16) != hipSuccess || per_cu < 1) { fprintf(stderr, "kernel_launch: occupancy query says %d\n", per_cu); per_cu = 1; }
        (void)hipGetLastError();
        grid = cus * per_cu;
        if (grid != 256) { fprintf(stderr, "kernel_launch: this build's phase schedule is laid out for 256 co-resident workgroups (one per CU of a 256-CU device); got %d; nothing launched\n", grid); grid = -1; return; }
    }
    if (grid < 0) return;
    if (hipMemsetAsync((char*)d_ws + WS_BAR, 0, XCD_BAR_BYTES, stream) != hipSuccess) { fprintf(stderr, "kernel_launch: memset of the barrier words failed\n"); return; }
    Args a{};
    for (int i = 0; i < 41; ++i) a.in[i] = (const float*)d_in[i];
    a.out = (float*)d_out; a.ws = (unsigned char*)d_ws;
#if MK_PER_PHASE
    for (int ph = 0; ph < NPHASE; ++ph) { a.ph_lo = ph; a.ph_hi = ph + 1; hipLaunchKernelGGL(mk, dim3(grid), dim3(512), LDS_BYTES + 16, stream, a); }
#else
    a.ph_lo = 0; a.ph_hi = NPHASE;
    void* args[] = {&a};
    hipError_t e = hipLaunchCooperativeKernel((const void*)mk, dim3(grid), dim3(512), args, LDS_BYTES + 16, stream);
    if (e != hipSuccess) fprintf(stderr, "cooperative launch failed: %s (grid %d)\n", hipGetErrorString(e), grid);
#endif
}
```

```cpp
#include <hip/hip_runtime.h>
#include <hip/hip_cooperative_groups.h>
#include <cstdio>
#include <cstdint>
namespace cg = cooperative_groups;

#ifndef MK_PER_PHASE
#define MK_PER_PHASE 0
#endif

#ifndef DBLMASK
#define DBLMASK 0u
#endif
#ifndef PHMASK
#define PHMASK 0xffffffffu
#endif
#define PH_ON(k) (((PHMASK) >> (k)) & 1u)
#define LAS __attribute__((address_space(3)))
typedef unsigned short bf16_t;
typedef short bf16x8 __attribute__((ext_vector_type(8)));
typedef short bf16x4 __attribute__((ext_vector_type(4)));
typedef float f32x4 __attribute__((ext_vector_type(4)));
typedef unsigned u32x4 __attribute__((ext_vector_type(4)));
typedef unsigned u32x2 __attribute__((ext_vector_type(2)));

constexpr int T = 34816, TP = 32768, DM = 1024, FF = 2816, KVROWS = 67584, NCH = 544, UP_LD = 1152, EV_LD = 2304;
constexpr float EPS = 1e-6f;
constexpr int NPHASE = 26;
constexpr size_t XCD_BAR_BYTES = 3456 * 4;
constexpr size_t O_Y = 0, O_LATP = 35651584, O_KRP = O_LATP + 8388608, O_CONVP = O_KRP + 1048576, O_SREP = O_CONVP + 16384, O_SIMP = O_SREP + 65536,
                 O_MKP = O_SIMP + 65536, O_MVP = O_MKP + 8388608, O_LATS = O_MVP + 8388608, O_KRS = O_LATS + 524288, O_CONVS = O_KRS + 65536,
                 O_SRES = O_CONVS + 32768, O_SIMS = O_SRES + 131072, O_END = O_SIMS + 131072;
constexpr size_t al(size_t x) { return (x + 255) & ~(size_t)255; }
constexpr size_t W_GU_A = 0, SZ_GU = (size_t)5632 * 1024 * 2, W_DN_A = W_GU_A + SZ_GU, SZ_DN = (size_t)1024 * 2816 * 2, W_GU_B = W_DN_A + SZ_DN, W_DN_B = W_GU_B + SZ_GU,
                 W_INE = W_DN_B + SZ_DN, W_UQ = W_INE + (size_t)2304 * 1024 * 2, W_UKV = W_UQ + (size_t)768 * 256 * 2, W_OUT = W_UKV + (size_t)1024 * 256 * 2,
                 W_INO = W_OUT + (size_t)1024 * 1024 * 2, W_GLU = W_INO + (size_t)1024 * 1024 * 2, W_XQ = W_GLU + (size_t)2048 * 1024 * 2, W_XO = W_XQ + (size_t)2 * 1024 * 1024 * 2,
                 W_MEM = W_XO + (size_t)2 * 1024 * 1024 * 2, XB = W_MEM + (size_t)4096 * 1024 * 2, SS = XB + (size_t)T * 1024 * 2, SSMEM = SS + (size_t)T * 32 * 4,
                 KLAG = SSMEM + (size_t)4096 * 32 * 4, BIG = KLAG + (size_t)64 * 64 * 256 * 4;
constexpr size_t HBUF = BIG, SZ_HBUF = (size_t)T * FF * 2;
constexpr size_t EVB = BIG, KVB = BIG, CQN = BIG + (size_t)T * EV_LD * 2, LATALL = BIG + SZ_HBUF, KRB = LATALL + (size_t)KVROWS * 256 * 2, QB = KRB + (size_t)KVROWS * 32 * 2,
                 MEMB = QB, MIXCAT = QB + (size_t)T * 768 * 2;
constexpr size_t QX = BIG, ATTX = BIG + (size_t)T * 1024 * 2, KXB = ATTX + (size_t)T * 1024 * 2, VXT = KXB + (size_t)48 * 262144 * 2;
constexpr size_t UPACK = BIG, YBUF = al(BIG + (size_t)64 * NCH * UP_LD * 2), EBUF = YBUF + (size_t)T * 1024 * 2, BTY = BIG + SZ_HBUF, BTE = BTY + (size_t)64 * 1024 * UP_LD * 2;
constexpr size_t WS_BAR = BTE + (size_t)64 * 128 * 1024 * 2 + (size_t)(1 << 20), WS_END = WS_BAR + XCD_BAR_BYTES;
static_assert(CQN + (size_t)T * 256 * 2 <= BIG + SZ_HBUF, "cqn overlaps latall");
static_assert(EBUF + (size_t)64 * NCH * 128 * 4 <= BTY, "ssm bufs overlap");
static_assert(MIXCAT + (size_t)T * 1024 * 2 <= WS_END, "mixcat");

__device__ __forceinline__ unsigned pk2(float lo, float hi) { unsigned r; asm("v_cvt_pk_bf16_f32 %0, %1, %2" : "=v"(r) : "v"(lo), "v"(hi)); return r; }
__device__ __forceinline__ float bf_lo(unsigned w) { return __uint_as_float(w << 16); }
__device__ __forceinline__ float bf_hi(unsigned w) { return __uint_as_float(w & 0xffff0000u); }
__device__ __forceinline__ float bf2f(unsigned short h) { return __uint_as_float((unsigned)h << 16); }
__device__ __forceinline__ unsigned short f2bf(float f) { return (unsigned short)(pk2(f, 0.f) & 0xffffu); }
__device__ __forceinline__ float red_sum16(float x) { const auto r = __builtin_amdgcn_permlane16_swap(__float_as_uint(x), __float_as_uint(x), false, false); return __uint_as_float(r[0]) + __uint_as_float(r[1]); }
__device__ __forceinline__ float red_sum32(float x) { const auto r = __builtin_amdgcn_permlane32_swap(__float_as_uint(x), __float_as_uint(x), false, false); return __uint_as_float(r[0]) + __uint_as_float(r[1]); }
__device__ __forceinline__ float red_max16(float x) { const auto r = __builtin_amdgcn_permlane16_swap(__float_as_uint(x), __float_as_uint(x), false, false); return fmaxf(__uint_as_float(r[0]), __uint_as_float(r[1])); }
__device__ __forceinline__ float red_max32(float x) { const auto r = __builtin_amdgcn_permlane32_swap(__float_as_uint(x), __float_as_uint(x), false, false); return fmaxf(__uint_as_float(r[0]), __uint_as_float(r[1])); }
__device__ __forceinline__ float wave_sum(float v) {
#pragma unroll
    for (int o = 1; o < 16; o <<= 1) v += __shfl_xor(v, o);
    return red_sum32(red_sum16(v));
}
__device__ __forceinline__ float lane_xor32(float x, int fq) { const auto r = __builtin_amdgcn_permlane32_swap(__float_as_uint(x), __float_as_uint(x), false, false); return __uint_as_float(fq < 2 ? r[1] : r[0]); }
__device__ __forceinline__ float fast_rcp(float x) { return __builtin_amdgcn_rcpf(x); }
__device__ __forceinline__ float fast_exp(float x) { return __builtin_amdgcn_exp2f(x * 1.44269504f); }
__device__ __forceinline__ float sigmoidf_(float x) { return fast_rcp(1.0f + fast_exp(-x)); }
__device__ __forceinline__ float rope_ift(int ii) { return __builtin_amdgcn_exp2f(-(float)ii * 0.83048202f) * 0.15915494f; }
__device__ __forceinline__ void cis_turns(float t, float& c, float& s) { t = t - floorf(t); c = __builtin_amdgcn_cosf(t); s = __builtin_amdgcn_sinf(t); }
__device__ __forceinline__ void cpow(float are, float aim, float dt, float d, float& pr, float& pi) {
    const float mag = __expf(d * are * dt); float c, s; cis_turns(d * (aim * dt * 0.15915494f), c, s); pr = mag * c; pi = mag * s;
}
__device__ __forceinline__ float row_rstd(const float* ss, int row, int fq, int np) {
    float s;
    if (np == 16) { const f32x4 v = *(const f32x4*)(ss + (size_t)row * 32 + 4 * fq); s = (v.x + v.y) + (v.z + v.w); }
    else { const f32x4 v = *(const f32x4*)(ss + (size_t)row * 32 + 8 * fq), w = *(const f32x4*)(ss + (size_t)row * 32 + 8 * fq + 4); s = ((v.x + v.y) + (v.z + v.w)) + ((w.x + w.y) + (w.z + w.w)); }
    s = red_sum32(red_sum16(s));
    return rsqrtf(s * (1.0f / 1024.0f) + EPS);
}


#define XB_TMO      128
#define XB_XCNT(j)  (256  + 64 * (j))
#define XB_XSUB(j)  (1280 + 64 * (j))
#define XB_XGEN(j)  (2304 + 64 * (j))
#define XB_TOP      3328
#define XB_TOPGEN   3392
#define XCD_BAR_WORDS 3456
#define XB_SPIN_CAP (1u << 18)
__device__ __forceinline__ unsigned xb_ld(unsigned* p)              { return __hip_atomic_load(p, __ATOMIC_RELAXED, __HIP_MEMORY_SCOPE_AGENT); }
__device__ __forceinline__ unsigned xb_add(unsigned* p, unsigned v) { return __hip_atomic_fetch_add(p, v, __ATOMIC_RELAXED, __HIP_MEMORY_SCOPE_AGENT); }
__device__ __forceinline__ unsigned xb_xcc_id() { return (unsigned)__builtin_amdgcn_s_getreg((3 << 11) | 20) & 0xFu; }
#define XB_SPIN(cond, bar) do { unsigned _sp = 0; while (cond) { __builtin_amdgcn_s_sleep(1); \
    if ((++_sp & 255u) == 0u) { if (xb_ld(&(bar)[XB_TMO])) break; if (_sp > XB_SPIN_CAP) { atomicAdd(&(bar)[XB_TMO], 1u); break; } } } } while (0)
struct XcdBarrier { unsigned* bar; unsigned x; volatile LAS unsigned* st; };
__device__ __forceinline__ XcdBarrier xcd_barrier_post(unsigned* bar, volatile LAS unsigned* st) {
    XcdBarrier b; b.bar = bar; b.x = xb_xcc_id(); b.st = st;
    if (threadIdx.x == 0) (void)xb_add(&bar[XB_XCNT(b.x)], 1u);
    return b;
}
__device__ __forceinline__ void xcd_barrier_complete(unsigned* bar, unsigned x, unsigned& nloc, unsigned& nx) {
    const unsigned G = gridDim.x * gridDim.y * gridDim.z;
    unsigned sum, cnt, mine, sp = 0u;
    for (;;) {
        sum = 0u; cnt = 0u; mine = 0u;
#pragma unroll
        for (unsigned j = 0; j < 16; ++j) { const unsigned c = xb_ld(&bar[XB_XCNT(j)]); sum += c; cnt += (c > 0u) ? 1u : 0u; mine = (j == x) ? c : mine; }
        if (sum == G) break;
        __builtin_amdgcn_s_sleep(1);
        if ((++sp & 255u) == 0u) { if (xb_ld(&bar[XB_TMO])) break; if (sp > XB_SPIN_CAP) { atomicAdd(&bar[XB_TMO], 1u); break; } }
    }
    nloc = mine > 0u ? mine : 1u; nx = cnt > 0u ? cnt : 1u;
}
__device__ __forceinline__ void xcd_barrier(const XcdBarrier& b) {
    asm volatile("s_waitcnt vmcnt(0)" ::: "memory");
    __syncthreads();
    if (threadIdx.x == 0) {
        unsigned* bar = b.bar;
        __builtin_amdgcn_s_waitcnt(0);
        unsigned nloc = b.st[0], nx = b.st[1];
        if (nloc == 0u) { xcd_barrier_complete(bar, b.x, nloc, nx); b.st[0] = nloc; b.st[1] = nx; }
        const unsigned old = xb_add(&bar[XB_XSUB(b.x)], 1u);
        const unsigned gen = old / nloc;
        if (old + 1u == (gen + 1u) * nloc) {
            __builtin_amdgcn_fence(__ATOMIC_RELEASE, "agent");
            asm volatile("s_waitcnt vmcnt(0)" ::: "memory");
            const unsigned og = xb_add(&bar[XB_TOP], 1u);
            const unsigned tg = og / nx;
            if (og + 1u == (tg + 1u) * nx) xb_add(&bar[XB_TOPGEN], 1u);
            else XB_SPIN(xb_ld(&bar[XB_TOPGEN]) == tg, bar);
            __builtin_amdgcn_fence(__ATOMIC_ACQUIRE, "agent");
            xb_add(&bar[XB_XGEN(b.x)], 1u);
            asm volatile("s_waitcnt vmcnt(0)" ::: "memory");
        } else {
            XB_SPIN(xb_ld(&bar[XB_XGEN(b.x)]) == gen, bar);
            __builtin_amdgcn_fence(__ATOMIC_ACQUIRE, "agent");
            asm volatile("s_waitcnt vmcnt(0)" ::: "memory");
        }
    }
    __syncthreads();
}

__device__ __forceinline__ void row_rstd8(const float* ss, int row0, int fq, int np, float (&rs)[2][4]) {
    float sv[2][4];
#pragma unroll
    for (int ai = 0; ai < 2; ++ai)
#pragma unroll
        for (int m = 0; m < 4; ++m) { const int row = row0 + ai * 128 + m * 16;
            if (np == 16) { const f32x4 v = *(const f32x4*)(ss + (size_t)row * 32 + 4 * fq); sv[ai][m] = (v.x + v.y) + (v.z + v.w); }
            else { const f32x4 v = *(const f32x4*)(ss + (size_t)row * 32 + 8 * fq), w = *(const f32x4*)(ss + (size_t)row * 32 + 8 * fq + 4); sv[ai][m] = ((v.x + v.y) + (v.z + v.w)) + ((w.x + w.y) + (w.z + w.w)); } }
#pragma unroll
    for (int ai = 0; ai < 2; ++ai)
#pragma unroll
        for (int m = 0; m < 4; ++m) { const float t = red_sum32(red_sum16(sv[ai][m])); rs[ai][m] = rsqrtf(t * (1.0f / 1024.0f) + EPS); }
}

namespace pg8 {
constexpr int BM = 256, BK = 64, HALF = 128, HTB = HALF * BK * 2, STAGE_BYTES = 8 * HTB;
__device__ __forceinline__ int lds_byte(int r, int c) { const int st = (r >> 4) * 2 + (c >> 5), rr = r & 15, cc = c & 31, ob = rr * 64 + cc * 2; return st * 1024 + (ob ^ (((ob >> 9) & 1) << 5)); }
__device__ __forceinline__ void stage_rc(int b, int& R, int& C) { const int st = b / 1024, sb = b % 1024, swz = sb ^ (((sb >> 9) & 1) << 5); R = (st >> 1) * 16 + swz / 64; C = (st & 1) * 32 + (swz % 64) / 2; }
__device__ __forceinline__ int perm32(int rho) { const int n = rho >> 4, i = rho & 15; return 8 * (i >> 2) + 4 * n + (i & 3); }
struct Unit { int pm, pn, pb; };
struct Gemm { const bf16_t* A; const bf16_t* Bt; int lda, ldb, K, nM, nN, nB; long sA, sB; int tri, amode, order, rot; };
__device__ __forceinline__ void remap_tile(int wgid, int nM, int nN, int& pm, int& pn) {
    const int nwg = nM * nN;
    { const int q = nwg / 8, r = nwg % 8, xcd = wgid % 8, off = wgid / 8; wgid = (xcd < r ? xcd * (q + 1) : r * (q + 1) + (xcd - r) * q) + off; }
    const int nig = 8 * nN, gid = wgid / nig, fm = gid * 8, gsz = (nM - fm) < 8 ? (nM - fm) : 8;
    pm = fm + ((wgid % nig) % gsz); pn = (wgid % nig) / gsz;
}
__device__ __forceinline__ bool next_unit(const Gemm& g, int i, Unit& u) {
    if (g.order) {
        const int c = (int)blockIdx.x; u.pb = 0; int p = -1;
        if (g.order == 1) { if (i) return false; if (c < 176) { u.pm = 128 + c / 22; u.pn = c % 22; return true; } p = c; }
        else if (g.order == 2) {
            if (c < 176) { if (i > 10) return false; p = i * 256 + c; }
            else if (c < 208) { if (i > 10) return false; p = i < 10 ? (i + 1) * 256 + c : 10 * 256 + c + 48; }
            else if (c < 224) { if (i > 9) return false; p = (i + 1) * 256 + c; }
            else { if (i > 8) return false; p = (i + 1) * 256 + c; }
        } else { if (i || c < 224) return false; const int t = c - 224; u.pm = 128 + (t >> 2); u.pn = t & 3; return true; }
        remap_tile(p, 128, 22, u.pm, u.pn); return true;
    }
    const int nwg = g.nM * g.nN;
    if (g.nB > 1) {
        const int G8 = (int)gridDim.x >> 3, x = (int)blockIdx.x & 7, q = i * G8 + ((int)blockIdx.x >> 3), gi = q / nwg, pb = x + 8 * gi;
        if ((gridDim.x & 7) != 0 || pb >= g.nB) { if ((gridDim.x & 7) == 0) return false; }
        else { const int r = q % nwg; u.pb = pb; u.pm = r / g.nN; u.pn = (r % g.nN + (g.tri ? i : 0)) % g.nN; return true; }
    }
    const long L = (long)i * gridDim.x + (blockIdx.x + (unsigned)g.rot) % gridDim.x; if (L >= (long)nwg * g.nB) return false;
    u.pb = (int)(L / nwg); int wgid = (int)(L % nwg);
    { const int q = nwg / 8, r = nwg % 8, xcd = wgid % 8, off = wgid / 8; wgid = (xcd < r ? xcd * (q + 1) : r * (q + 1) + (xcd - r) * q) + off; }
    const int nig = 8 * g.nN, gid = wgid / nig, fm = gid * 8, gsz = (g.nM - fm) < 8 ? (g.nM - fm) : 8;
    u.pm = fm + ((wgid % nig) % gsz); u.pn = (wgid % nig) / gsz; return true;
}
template <class Epi>
__device__ __forceinline__ void gemm_phase(LAS unsigned char* lds, const Gemm g, const Epi& E) {
    const int tid = threadIdx.x, wid = __builtin_amdgcn_readfirstlane(tid >> 6), lane = tid & 63, wr = wid >> 2, wc = wid & 3, fr = lane & 15, fq = lane >> 4;
    int nt_all = g.K / BK; asm volatile("" : "+s"(nt_all));
    unsigned voffA[2], voffB[2];
#pragma unroll
    for (int i = 0; i < 2; ++i) { int R, C; stage_rc(tid * 16 + i * 8192, R, C); const int Rb = (R & ~31) + perm32(R & 31);
        voffA[i] = g.amode ? (unsigned)(((size_t)(C >> 4) * g.sA + R * 16 + (C & 15)) * 2) : (unsigned)(R * g.lda + C) * 2u; voffB[i] = (unsigned)(Rb * g.ldb + C) * 2u; }
    const size_t kstep = (size_t)(BK * 2), kstepA = g.amode ? (size_t)g.sA * 8 : kstep;
    const size_t hsA = (size_t)HALF * g.lda * 2, hsB = (size_t)HALF * g.ldb * 2;
    const unsigned ldsw = (unsigned)wid * 1024u;
    const int aoff = lds_byte(wr * 64 + fr, fq * 8), boff = lds_byte(wc * 32 + fr, fq * 8);
#define PG8_SA(b, h) (((b) * 2 + (h)) * HTB)
#define PG8_SB(b, h) ((4 + (b) * 2 + (h)) * HTB)
#define PG8_STAGE(bufoff, gbase, voff) do { _Pragma("unroll") for (int _i = 0; _i < 2; ++_i) \
        __builtin_amdgcn_global_load_lds((const unsigned*)((const char*)(gbase) + (voff)[_i]), (LAS unsigned*)(lds + (bufoff) + ldsw + _i * 8192), 16, 0, 0); } while (0)
#define PG8_LDA(dst, b, h) do { _Pragma("unroll") for (int m = 0; m < 4; ++m) _Pragma("unroll") for (int k = 0; k < 2; ++k) dst[m][k] = *(const LAS bf16x8*)(lds + PG8_SA(b, h) + aoff + m * 2048 + k * 1024); } while (0)
#define PG8_LDB(dst, b, h) do { _Pragma("unroll") for (int n = 0; n < 2; ++n) _Pragma("unroll") for (int k = 0; k < 2; ++k) dst[n][k] = *(const LAS bf16x8*)(lds + PG8_SB(b, h) + boff + n * 2048 + k * 1024); } while (0)
#define PG8_MMA(ai, bj, At, Bt) do { __builtin_amdgcn_s_setprio(1); _Pragma("unroll") for (int m = 0; m < 4; ++m) _Pragma("unroll") for (int n = 0; n < 2; ++n) _Pragma("unroll") for (int k = 0; k < 2; ++k) \
        acc[ai][bj][m][n] = __builtin_amdgcn_mfma_f32_16x16x32_bf16(Bt[n][k], At[m][k], acc[ai][bj][m][n], 0, 0, 0); __builtin_amdgcn_s_setprio(0); } while (0)
#define PG8_WAIT_V(n) asm volatile("s_waitcnt vmcnt(" #n ")" ::: "memory")
#define PG8_WAIT_L(n) asm volatile("s_waitcnt lgkmcnt(" #n ")" ::: "memory")
#define PG8_BAR __builtin_amdgcn_s_barrier()
#define PG8_SCHED __builtin_amdgcn_sched_barrier(0)
    Unit cur, nxt; int ui = 0;
    if (!next_unit(g, 0, cur)) return;
    f32x4 acc[2][2][4][2];
#pragma unroll
    for (int a = 0; a < 2; ++a)
#pragma unroll
        for (int b = 0; b < 2; ++b)
#pragma unroll
            for (int m = 0; m < 4; ++m)
#pragma unroll
                for (int n = 0; n < 2; ++n) acc[a][b][m][n] = (f32x4){0.f, 0.f, 0.f, 0.f};
    bf16x8 At[4][2], B0[2][2], B1[2][2];
    const char* cA = (const char*)g.A + ((size_t)cur.pb * g.sA + (size_t)cur.pm * BM * g.lda) * 2; const char* cB = (const char*)g.Bt + ((size_t)cur.pb * g.sB + (size_t)cur.pn * BM * g.ldb) * 2;
    PG8_STAGE(PG8_SB(0, 0), cB, voffB); PG8_STAGE(PG8_SB(0, 1), cB + hsB, voffB); PG8_STAGE(PG8_SA(0, 0), cA, voffA); PG8_STAGE(PG8_SA(0, 1), cA + hsA, voffA);
    if (wr == 1) PG8_BAR;
    PG8_WAIT_V(2); PG8_BAR;
    PG8_STAGE(PG8_SB(1, 0), cB + kstep, voffB); PG8_STAGE(PG8_SA(1, 0), cA + kstepA, voffA); PG8_STAGE(PG8_SB(1, 1), cB + hsB + kstep, voffB);
    PG8_WAIT_V(6); PG8_BAR;
    for (;;) {
        const bool has_next = next_unit(g, ui + 1, nxt);
        const char* nA = has_next ? (const char*)g.A + ((size_t)nxt.pb * g.sA + (size_t)nxt.pm * BM * g.lda) * 2 : cA;
        const char* nB = has_next ? (const char*)g.Bt + ((size_t)nxt.pb * g.sB + (size_t)nxt.pn * BM * g.ldb) * 2 : cB;
        const int nt = g.tri ? min(nt_all, 6 + 4 * cur.pn) : nt_all;
        for (int t = 0; t < nt; t += 2) {
            const bool last = (t == nt - 2);
            const char* a1 = cA + (size_t)(t + 1) * kstepA;
            const char* a2 = last ? nA : cA + (size_t)(t + 2) * kstepA; const char* b2 = last ? nB : cB + (size_t)(t + 2) * kstep;
            const char* a3 = a2 + kstepA; const char* b3 = b2 + kstep;
            PG8_LDB(B0, 0, 0); PG8_LDB(B1, 0, 1); PG8_SCHED; PG8_LDA(At, 0, 0); PG8_STAGE(PG8_SA(1, 1), a1 + hsA, voffA);
            PG8_WAIT_V(8); PG8_WAIT_L(0); PG8_BAR; PG8_MMA(0, 0, At, B0); PG8_MMA(0, 1, At, B1); PG8_BAR; PG8_SCHED;
            PG8_LDA(At, 0, 1); PG8_STAGE(PG8_SB(0, 0), b2, voffB); PG8_STAGE(PG8_SB(0, 1), b2 + hsB, voffB); PG8_STAGE(PG8_SA(0, 0), a2, voffA);
            PG8_WAIT_V(8); PG8_WAIT_L(0); PG8_BAR; PG8_MMA(1, 0, At, B0); PG8_MMA(1, 1, At, B1); PG8_BAR; PG8_SCHED;
            PG8_LDB(B0, 1, 0); PG8_LDB(B1, 1, 1); PG8_SCHED; PG8_LDA(At, 1, 0); PG8_STAGE(PG8_SA(0, 1), a2 + hsA, voffA);
            PG8_WAIT_V(8); PG8_WAIT_L(0); PG8_BAR; PG8_MMA(0, 0, At, B0); PG8_MMA(0, 1, At, B1); PG8_BAR; PG8_SCHED;
            PG8_LDA(At, 1, 1); PG8_STAGE(PG8_SB(1, 0), b3, voffB); PG8_STAGE(PG8_SB(1, 1), b3 + hsB, voffB); PG8_STAGE(PG8_SA(1, 0), a3, voffA);
            PG8_WAIT_V(8); PG8_WAIT_L(0); PG8_BAR; PG8_MMA(1, 0, At, B0); PG8_MMA(1, 1, At, B1); PG8_BAR; PG8_SCHED;
        }
        if (wr == 0) PG8_BAR;
        E(acc, cur, wr, wc, fr, fq);
        if (!has_next) break;
#pragma unroll
        for (int a = 0; a < 2; ++a)
#pragma unroll
            for (int b = 0; b < 2; ++b)
#pragma unroll
                for (int m = 0; m < 4; ++m)
#pragma unroll
                    for (int n = 0; n < 2; ++n) acc[a][b][m][n] = (f32x4){0.f, 0.f, 0.f, 0.f};
        cur = nxt; cA = nA; cB = nB; ++ui;
        if (wr == 1) PG8_BAR;
    }
    PG8_WAIT_V(0);
    PG8_BAR;
#undef PG8_SA
#undef PG8_SB
#undef PG8_STAGE
#undef PG8_LDA
#undef PG8_LDB
#undef PG8_MMA
#undef PG8_WAIT_V
#undef PG8_WAIT_L
#undef PG8_BAR
#undef PG8_SCHED
}
typedef f32x4 Acc[2][2][4][2];

struct EpiSwiglu { bf16_t* H; const float* ss; int np;
    __device__ __forceinline__ void operator()(const Acc& acc, const Unit& u, int wr, int wc, int fr, int fq) const {
        const int row0 = u.pm * BM + wr * 64 + fr, col0 = u.pn * 128 + wc * 32 + 8 * fq;
        float rsv[2][4]; row_rstd8(ss, row0, fq, np, rsv);
#pragma unroll
        for (int ai = 0; ai < 2; ++ai)
#pragma unroll
            for (int m = 0; m < 4; ++m) { const int row = row0 + ai * HALF + m * 16; const float rs = rsv[ai][m];
                float h[8];
#pragma unroll
                for (int n = 0; n < 2; ++n)
#pragma unroll
                    for (int j = 0; j < 4; ++j) { const float gt = acc[ai][0][m][n][j] * rs, up = acc[ai][1][m][n][j] * rs; h[n * 4 + j] = gt * sigmoidf_(gt) * up; }
                u32x4 w; w.x = pk2(h[0], h[1]); w.y = pk2(h[2], h[3]); w.z = pk2(h[4], h[5]); w.w = pk2(h[6], h[7]);
                *(u32x4*)(H + (size_t)row * FF + col0) = w; }
    }
};
struct EpiResid { bf16_t* XBp; float* ss; float alpha;
    __device__ __forceinline__ void operator()(const Acc& acc, const Unit& u, int wr, int wc, int fr, int fq) const {
        const int row0 = u.pm * BM + wr * 64 + fr, col0 = u.pn * BM + wc * 32 + 8 * fq;
#pragma unroll
        for (int ai = 0; ai < 2; ++ai) {
            u32x4 xo[4][2];
#pragma unroll
            for (int m = 0; m < 4; ++m)
#pragma unroll
                for (int bj = 0; bj < 2; ++bj) xo[m][bj] = *(const u32x4*)(XBp + (size_t)(row0 + ai * HALF + m * 16) * DM + col0 + bj * HALF);
#pragma unroll
            for (int m = 0; m < 4; ++m) { const int row = row0 + ai * HALF + m * 16; float sq = 0.f;
#pragma unroll
                for (int bj = 0; bj < 2; ++bj) { bf16_t* p = XBp + (size_t)row * DM + col0 + bj * HALF; const u32x4 xv = xo[m][bj];
                    f32x4 x0 = (f32x4){bf_lo(xv.x), bf_hi(xv.x), bf_lo(xv.y), bf_hi(xv.y)}, x1 = (f32x4){bf_lo(xv.z), bf_hi(xv.z), bf_lo(xv.w), bf_hi(xv.w)};
                    x0 = x0 + alpha * acc[ai][bj][m][0]; x1 = x1 + alpha * acc[ai][bj][m][1];
                    u32x4 w; w.x = pk2(x0.x, x0.y); w.y = pk2(x0.z, x0.w); w.z = pk2(x1.x, x1.y); w.w = pk2(x1.z, x1.w);
                    *(u32x4*)p = w;
                    sq += (x0.x * x0.x + x0.y * x0.y) + (x0.z * x0.z + x0.w * x0.w) + (x1.x * x1.x + x1.y * x1.y) + (x1.z * x1.z + x1.w * x1.w); }
                sq = red_sum32(red_sum16(sq));
                if (fq == 0) ss[(size_t)row * 32 + u.pn * 4 + wc] = sq; }
        }
    }
};
struct EpiGluResid { bf16_t* XBp; float* ss; float mul;
    __device__ __forceinline__ void operator()(const Acc& acc, const Unit& u, int wr, int wc, int fr, int fq) const {
        const int row0 = u.pm * BM + wr * 64 + fr, col0 = u.pn * 128 + wc * 32 + 8 * fq;
        u32x4 xo[2][4];
#pragma unroll
        for (int ai = 0; ai < 2; ++ai)
#pragma unroll
            for (int m = 0; m < 4; ++m) xo[ai][m] = *(const u32x4*)(XBp + (size_t)(row0 + ai * HALF + m * 16) * DM + col0);
#pragma unroll
        for (int ai = 0; ai < 2; ++ai)
#pragma unroll
            for (int m = 0; m < 4; ++m) { const int row = row0 + ai * HALF + m * 16; bf16_t* p = XBp + (size_t)row * DM + col0; const u32x4 xv = xo[ai][m];
                f32x4 x0 = (f32x4){bf_lo(xv.x), bf_hi(xv.x), bf_lo(xv.y), bf_hi(xv.y)}, x1 = (f32x4){bf_lo(xv.z), bf_hi(xv.z), bf_lo(xv.w), bf_hi(xv.w)};
#pragma unroll
                for (int j = 0; j < 4; ++j) { x0[j] += mul * acc[ai][0][m][0][j] * sigmoidf_(acc[ai][1][m][0][j]); x1[j] += mul * acc[ai][0][m][1][j] * sigmoidf_(acc[ai][1][m][1][j]); }
                u32x4 w; w.x = pk2(x0.x, x0.y); w.y = pk2(x0.z, x0.w); w.z = pk2(x1.x, x1.y); w.w = pk2(x1.z, x1.w);
                *(u32x4*)p = w;
                float sq = (x0.x * x0.x + x0.y * x0.y) + (x0.z * x0.z + x0.w * x0.w) + (x1.x * x1.x + x1.y * x1.y) + (x1.z * x1.z + x1.w * x1.w);
                sq = red_sum32(red_sum16(sq));
                if (fq == 0) ss[(size_t)row * 32 + u.pn * 4 + wc] = sq; }
    }
};
template <bool SCALE> struct EpiBf { bf16_t* O; int ldc; const float* ss; int np; float mul;
    __device__ __forceinline__ void operator()(const Acc& acc, const Unit& u, int wr, int wc, int fr, int fq) const {
        const int row0 = u.pm * BM + wr * 64 + fr, col0 = u.pn * BM + wc * 32 + 8 * fq;
        float rsv[2][4]; if (SCALE) row_rstd8(ss, row0, fq, np, rsv);
#pragma unroll
        for (int ai = 0; ai < 2; ++ai)
#pragma unroll
            for (int m = 0; m < 4; ++m) { const int row = row0 + ai * HALF + m * 16; float rs = mul; if (SCALE) rs *= rsv[ai][m];
#pragma unroll
                for (int bj = 0; bj < 2; ++bj) { const f32x4 v0 = acc[ai][bj][m][0] * rs, v1 = acc[ai][bj][m][1] * rs;
                    u32x4 w; w.x = pk2(v0.x, v0.y); w.y = pk2(v0.z, v0.w); w.z = pk2(v1.x, v1.y); w.w = pk2(v1.z, v1.w);
                    *(u32x4*)(O + (size_t)row * ldc + col0 + bj * HALF) = w; } }
    }
};
struct EpiU { bf16_t* U; const float* ss; int np;
    __device__ __forceinline__ void operator()(const Acc& acc, const Unit& u, int wr, int wc, int fr, int fq) const {
        const int row0 = u.pm * BM + wr * 64 + fr, col0 = u.pn * BM + wc * 32 + 8 * fq;
        float rsv[2][4]; row_rstd8(ss, row0, fq, np, rsv);
#pragma unroll
        for (int ai = 0; ai < 2; ++ai)
#pragma unroll
            for (int m = 0; m < 4; ++m) { const int row = row0 + ai * HALF + m * 16; const float rs = rsv[ai][m]; const int chunk = row >> 6, j = row & 63;
#pragma unroll
                for (int bj = 0; bj < 2; ++bj) { const int col = col0 + bj * HALF, gg = col >> 4, cp = col & 15; const f32x4 v0 = acc[ai][bj][m][0] * rs, v1 = acc[ai][bj][m][1] * rs;
                    u32x4 w; w.x = pk2(v0.x, v0.y); w.y = pk2(v0.z, v0.w); w.z = pk2(v1.x, v1.y); w.w = pk2(v1.z, v1.w);
                    *(u32x4*)(U + ((size_t)gg * NCH + chunk) * UP_LD + 128 + j * 16 + cp) = w; } }
    }
};
struct EpiMemKV { float* out; const float* ss;
    __device__ __forceinline__ void operator()(const Acc& acc, const Unit& u, int wr, int wc, int fr, int fq) const {
        const int row0 = u.pm * BM + wr * 64 + fr, l = u.pn >> 3, kv = (u.pn >> 2) & 1, col0 = (u.pn & 3) * BM + wc * 32 + 8 * fq;
        float* base = out + (kv ? O_MVP : O_MKP) + (size_t)l * 4096 * 1024;
#pragma unroll
        for (int ai = 0; ai < 2; ++ai)
#pragma unroll
            for (int m = 0; m < 4; ++m) { const int row = row0 + ai * HALF + m * 16; const float rs = row_rstd(ss, row, fq, 16);
#pragma unroll
                for (int bj = 0; bj < 2; ++bj) { float* p = base + (size_t)row * 1024 + col0 + bj * HALF; *(f32x4*)p = acc[ai][bj][m][0] * rs; *(f32x4*)(p + 4) = acc[ai][bj][m][1] * rs; } }
    }
};
struct EpiE { float* Eo;
    __device__ __forceinline__ void operator()(const Acc& acc, const Unit& u, int wr, int wc, int fr, int fq) const {
        const int row0 = u.pm * BM + wr * 64 + fr, col0 = wc * 32 + 8 * fq;
#pragma unroll
        for (int ai = 0; ai < 2; ++ai)
#pragma unroll
            for (int m = 0; m < 4; ++m) { const int row = row0 + ai * HALF + m * 16;
                if (row < NCH) { float* p = Eo + ((size_t)u.pb * NCH + row) * 128 + col0; *(f32x4*)p = acc[ai][0][m][0]; *(f32x4*)(p + 4) = acc[ai][0][m][1]; } }
    }
};
struct EpiY { bf16_t* Y; const bf16_t* U; const float* dsk;
    __device__ __forceinline__ void operator()(const Acc& acc, const Unit& u, int wr, int wc, int fr, int fq) const {
        const int row0 = u.pm * BM + wr * 64 + fr, col0 = u.pn * BM + wc * 32 + 8 * fq, c = col0 & 15;
        const f32x4 d0 = *(const f32x4*)(dsk + u.pb * 16 + c), d1 = *(const f32x4*)(dsk + u.pb * 16 + c + 4);
        u32x4 uv[2][4][2];
#pragma unroll
        for (int ai = 0; ai < 2; ++ai)
#pragma unroll
            for (int m = 0; m < 4; ++m)
#pragma unroll
                for (int bj = 0; bj < 2; ++bj) { const int row = min(row0 + ai * HALF + m * 16, NCH - 1); uv[ai][m][bj] = *(const u32x4*)(U + ((size_t)u.pb * NCH + row) * UP_LD + 128 + col0 + bj * HALF); }
#pragma unroll
        for (int ai = 0; ai < 2; ++ai)
#pragma unroll
            for (int m = 0; m < 4; ++m) { const int row = row0 + ai * HALF + m * 16;
                if (row < NCH) {
#pragma unroll
                    for (int bj = 0; bj < 2; ++bj) { const int n = col0 + bj * HALF, l = n >> 4;
                        const u32x4 uu = uv[ai][m][bj];
                        float y[8];
                        y[0] = acc[ai][bj][m][0].x + d0.x * bf_lo(uu.x); y[1] = acc[ai][bj][m][0].y + d0.y * bf_hi(uu.x); y[2] = acc[ai][bj][m][0].z + d0.z * bf_lo(uu.y); y[3] = acc[ai][bj][m][0].w + d0.w * bf_hi(uu.y);
                        y[4] = acc[ai][bj][m][1].x + d1.x * bf_lo(uu.z); y[5] = acc[ai][bj][m][1].y + d1.y * bf_hi(uu.z); y[6] = acc[ai][bj][m][1].z + d1.z * bf_lo(uu.w); y[7] = acc[ai][bj][m][1].w + d1.w * bf_hi(uu.w);
#pragma unroll
                        for (int j = 0; j < 8; ++j) { const float v = y[j], z = 1.59576912f * (v + 0.044715f * v * v * v); y[j] = v * sigmoidf_(z); }
                        u32x4 w; w.x = pk2(y[0], y[1]); w.y = pk2(y[2], y[3]); w.z = pk2(y[4], y[5]); w.w = pk2(y[6], y[7]);
                        *(u32x4*)(Y + ((size_t)u.pb * T + (size_t)row * 64 + l) * 16 + c) = w; } } }
    }
};
}

template <int MODE>
__device__ __forceinline__ void attn_phase(LAS unsigned char* lds, const bf16_t* Q, const bf16_t* kvb, const bf16_t* krb, const bf16_t* kxb, const bf16_t* vxt, bf16_t* O) {
    constexpr int DQK = MODE ? 256 : 96, DV = MODE ? 256 : 64, KSTR = DQK + 8, VSTR = 72, NKS = DQK / 32, NDB = DV / 16, LDQ = MODE ? 1024 : 768;
    constexpr int HALF_BYTES = 64 * KSTR * 2 + DV * VSTR * 2, NITEM = MODE ? 1152 : 2304, NKR = MODE ? 4 : 2, NVR = MODE ? 4 : 1, NDW = NDB;
    const int tid = threadIdx.x, wid = __builtin_amdgcn_readfirstlane(tid >> 6), lane = tid & 63, w = wid, th = tid, fr = lane & 15, fq = lane >> 4;
    LAS bf16_t* Ks = (LAS bf16_t*)lds; LAS bf16_t* Vt = Ks + 64 * KSTR;
    for (int rnd = 0; rnd * (int)gridDim.x < NITEM; ++rnd) {
        const int it = rnd * (int)gridDim.x + ((MODE == 0 && (rnd & 1)) ? ((int)gridDim.x - 1 - (int)blockIdx.x) : (int)blockIdx.x);
        if (it >= NITEM) continue;
        int qrow0, ntiles, h, kvrow0 = 0, pos0 = 0, wq = w; bool wactive = true; const bf16_t* kbase = nullptr; const bf16_t* vbase = nullptr;
        int my_nt = 0;
        if (MODE == 0) {
            int L = it, b, j = -1;
            if (L < 1024) { j = 15 - (L >> 7); b = (L & 127) >> 3; h = L & 7; }
            else if (L < 1280) { L -= 1024; b = L >> 3; h = L & 7; }
            else { L -= 1280; j = 7 - (L >> 7); b = (L & 127) >> 3; h = L & 7; }
            if (j >= 0) { qrow0 = b * 2048 + 128 * j; kvrow0 = b * 2048; ntiles = 2 * j + 2; pos0 = 128 * j; my_nt = 2 * j + 1 + (w >> 2); }
            else { qrow0 = TP + b * 64; kvrow0 = TP + b * 1088; ntiles = 17; pos0 = 1024; wq = w & 3; wactive = w < 4; my_nt = wactive ? 17 : 0; }
        } else {
            int bg; h = it & 3; ntiles = 4;
            if (it < 1024) { bg = it >> 6; qrow0 = bg * 2048 + ((it >> 2) & 15) * 128; }
            else { const int b = (it - 1024) >> 2; bg = 16 + b; qrow0 = TP + b * 64; wq = w & 3; wactive = w < 4; }
            my_nt = 4;
            kbase = kxb + (size_t)bg * 262144 + h * 256; vbase = vxt + (size_t)(bg * 4 + h) * 65536;
        }
        bf16x8 qf[NKS];
        { const bf16_t* qp = Q + (size_t)(qrow0 + 16 * wq + fr) * LDQ + h * DQK + 8 * fq;
#pragma unroll
          for (int k = 0; k < NKS; ++k) qf[k] = *(const bf16x8*)(qp + 32 * k); }
        if (MODE == 0) {
            const float pos = (float)(pos0 + 16 * wq + fr); float y[8];
#pragma unroll
            for (int j = 0; j < 8; ++j) { const float x = bf2f((unsigned short)qf[2][j]), xp = lane_xor32(x, fq); float cs, sn; cis_turns(pos * rope_ift(8 * (fq & 1) + j), cs, sn);
                y[j] = (fq < 2) ? x * cs - xp * sn : xp * sn + x * cs; }
#pragma unroll
            for (int j = 0; j < 8; j += 2) { const unsigned pw = pk2(y[j], y[j + 1]); qf[2][j] = (short)(pw & 0xffffu); qf[2][j + 1] = (short)(pw >> 16); }
        }
        f32x4 ot[NDW];
#pragma unroll
        for (int d = 0; d < NDW; ++d) ot[d] = (f32x4){0.f, 0.f, 0.f, 0.f};
        float mrun = -1e30f, lrun = 0.f;
        u32x4 kr[NKR], vr[NVR];
#define ATT_LD(kt_) do { \
        if (MODE == 0) { \
            _Pragma("unroll") for (int r = 0; r < 2; ++r) { const int q = th + 512 * r; if (q < 768) { const int key = q / 12, pc = q % 12; const size_t krow = (size_t)(kvrow0 + 64 * (kt_) + key); \
                kr[r] = *(const u32x4*)(pc < 8 ? kvb + krow * 1024 + h * 128 + 8 * pc : krb + krow * 32 + 8 * (pc - 8)); } } \
            { const int key = th & 63, pc = th >> 6; const size_t krow = (size_t)(kvrow0 + 64 * (kt_) + key); \
                vr[0] = *(const u32x4*)(kvb + krow * 1024 + h * 128 + 64 + 8 * pc); } \
        } else { \
            _Pragma("unroll") for (int r = 0; r < 4; ++r) { const int q = th + 512 * r; kr[r] = *(const u32x4*)(kbase + (size_t)(64 * (kt_) + (q >> 5)) * 1024 + 8 * (q & 31)); \
                vr[r] = *(const u32x4*)(vbase + (size_t)(q >> 3) * 256 + 64 * (kt_) + 8 * (q & 7)); } \
        } } while (0)
        ATT_LD(0);
        for (int kt = 0; kt < ntiles; ++kt) {
            __syncthreads();
            if (MODE == 0) {
#pragma unroll
                for (int r = 0; r < 2; ++r) { const int q = th + 512 * r; if (q < 768) { const int key = q / 12, pc = q % 12; *(LAS u32x4*)(Ks + key * KSTR + 8 * pc) = kr[r]; } }
                { const int key = th & 63, pc = th >> 6; const u32x4 v = vr[0]; LAS bf16_t* d = Vt + (8 * pc) * VSTR + key;
                    d[0] = (bf16_t)(v.x & 0xffffu); d[VSTR] = (bf16_t)(v.x >> 16); d[2 * VSTR] = (bf16_t)(v.y & 0xffffu); d[3 * VSTR] = (bf16_t)(v.y >> 16);
                    d[4 * VSTR] = (bf16_t)(v.z & 0xffffu); d[5 * VSTR] = (bf16_t)(v.z >> 16); d[6 * VSTR] = (bf16_t)(v.w & 0xffffu); d[7 * VSTR] = (bf16_t)(v.w >> 16); }
            } else {
#pragma unroll
                for (int r = 0; r < 4; ++r) { const int q = th + 512 * r; *(LAS u32x4*)(Ks + (q >> 5) * KSTR + 8 * (q & 31)) = kr[r]; *(LAS u32x4*)(Vt + (q >> 3) * VSTR + 8 * (q & 7)) = vr[r]; }
            }
            __syncthreads();
            if (kt + 1 < ntiles) ATT_LD(kt + 1);
            if (kt < my_nt) {
            f32x4 st[4];
#pragma unroll
            for (int nb = 0; nb < 4; ++nb) { st[nb] = (f32x4){0.f, 0.f, 0.f, 0.f};
#pragma unroll
                for (int k = 0; k < NKS; ++k) { const bf16x8 a = *(const LAS bf16x8*)(Ks + (16 * nb + fr) * KSTR + 32 * k + 8 * fq); st[nb] = __builtin_amdgcn_mfma_f32_16x16x32_bf16(a, qf[k], st[nb], 0, 0, 0); } }
            float mx = -1e30f;
#pragma unroll
            for (int nb = 0; nb < 4; ++nb) mx = fmaxf(mx, fmaxf(fmaxf(st[nb].x, st[nb].y), fmaxf(st[nb].z, st[nb].w)));
            mx = red_max32(red_max16(mx));
            const float mnew = fmaxf(mrun, mx), alpha = __builtin_amdgcn_exp2f(mrun - mnew); mrun = mnew;
            float lsum = 0.f;
#pragma unroll
            for (int nb = 0; nb < 4; ++nb)
#pragma unroll
                for (int j = 0; j < 4; ++j) { const float p = __builtin_amdgcn_exp2f(st[nb][j] - mnew); st[nb][j] = p; lsum += p; }
            lrun = lrun * alpha + lsum;
#pragma unroll
            for (int d = 0; d < NDW; ++d) ot[d] = ot[d] * alpha;
#pragma unroll
            for (int k2 = 0; k2 < 2; ++k2) {
                bf16x8 pb; { const unsigned w0 = pk2(st[2 * k2].x, st[2 * k2].y), w1 = pk2(st[2 * k2].z, st[2 * k2].w), w2 = pk2(st[2 * k2 + 1].x, st[2 * k2 + 1].y), w3 = pk2(st[2 * k2 + 1].z, st[2 * k2 + 1].w);
                    pb[0] = (short)(w0 & 0xffffu); pb[1] = (short)(w0 >> 16); pb[2] = (short)(w1 & 0xffffu); pb[3] = (short)(w1 >> 16); pb[4] = (short)(w2 & 0xffffu); pb[5] = (short)(w2 >> 16); pb[6] = (short)(w3 & 0xffffu); pb[7] = (short)(w3 >> 16); }
#pragma unroll
                for (int d = 0; d < NDW; ++d) { const LAS bf16_t* vp_ = Vt + (16 * d + fr) * VSTR + 32 * k2 + 4 * fq;
                    const bf16x4 lo = *(const LAS bf16x4*)vp_, hi = *(const LAS bf16x4*)(vp_ + 16);
                    bf16x8 a; a[0] = lo[0]; a[1] = lo[1]; a[2] = lo[2]; a[3] = lo[3]; a[4] = hi[0]; a[5] = hi[1]; a[6] = hi[2]; a[7] = hi[3];
                    ot[d] = __builtin_amdgcn_mfma_f32_16x16x32_bf16(a, pb, ot[d], 0, 0, 0); }
            }
            }
        }
#undef ATT_LD
        const float lt = red_sum32(red_sum16(lrun)); const float inv = 1.0f / lt;
        bf16_t* op = O + (size_t)(qrow0 + 16 * wq + fr) * 1024 + h * DV + 4 * fq;
        if (wactive) {
#pragma unroll
            for (int d = 0; d < NDW; ++d) { u32x2 o; o.x = pk2(ot[d].x * inv, ot[d].y * inv); o.y = pk2(ot[d].z * inv, ot[d].w * inv); *(u32x2*)(op + 16 * d) = o; }
        }
    }
}

__device__ __forceinline__ void tr_loop(const float* W, int K, int N, const float* gain, bf16_t* WT, int row_off, int mode, LAS float* scr, int gw, int ngw, int lane) {
    const int nblk = N / 32, nitems = (K / 64) * nblk, half = N >> 1;
    for (int item = gw; item < nitems; item += ngw) {
        const int kb = item / nblk, nb = item % nblk, k0 = 64 * kb, n0 = 32 * nb;
#pragma unroll 8
        for (int i = 0; i < 32; ++i) { const int kk = 2 * i + (lane >> 5); float v = W[(size_t)(k0 + kk) * N + n0 + (lane & 31)]; if (gain) v *= gain[k0 + kk]; scr[kk * 33 + (lane & 31)] = v; }
        asm volatile("s_waitcnt lgkmcnt(0)" ::: "memory");
        const int c = lane & 7;
#pragma unroll
        for (int j = 0; j < 4; ++j) { const int n = (lane >> 3) + 8 * j; const LAS float* s = scr + (8 * c) * 33 + n;
            u32x4 o; o.x = pk2(s[0], s[33]); o.y = pk2(s[66], s[99]); o.z = pk2(s[132], s[165]); o.w = pk2(s[198], s[231]);
            const int col = n0 + n; int row;
            if (mode == 0) row = row_off + col; else { const int hs = col >= half ? 1 : 0, cc = col - hs * half; row = (cc >> 7) * 256 + hs * 128 + (cc & 127); }
            *(u32x4*)(WT + (size_t)row * K + k0 + 8 * c) = o; }
        asm volatile("s_waitcnt lgkmcnt(0)" ::: "memory");
    }
}

constexpr int LDS_BYTES = 2 * (64 * 264 * 2 + 256 * 72 * 2);
struct Args { const float* in[41]; float* out; unsigned char* ws; int ph_lo, ph_hi; };

__device__ __forceinline__ void tr_weight_job(const Args& a, unsigned char* ws, int j, LAS float* scr, int gw, int ngw, int lane) {
                const float* W; const float* gain = nullptr; bf16_t* WT; int K, N, mode = 0, roff = 0;
                switch (j) {
                    case 0: W = a.in[11]; gain = a.in[10]; WT = (bf16_t*)(ws + W_GU_A); K = 1024; N = 5632; mode = 1; break;
                    case 1: W = a.in[12]; WT = (bf16_t*)(ws + W_DN_A); K = 2816; N = 1024; break;
                    case 2: W = a.in[38]; gain = a.in[37]; WT = (bf16_t*)(ws + W_GU_B); K = 1024; N = 5632; mode = 1; break;
                    case 3: W = a.in[39]; WT = (bf16_t*)(ws + W_DN_B); K = 2816; N = 1024; break;
                    case 4: W = a.in[14]; gain = a.in[13]; WT = (bf16_t*)(ws + W_INE); K = 1024; N = 2080; break;
                    case 5: W = a.in[17]; WT = (bf16_t*)(ws + W_UQ); K = 256; N = 768; break;
                    case 6: W = a.in[18]; WT = (bf16_t*)(ws + W_UKV); K = 256; N = 1024; break;
                    case 7: W = a.in[20]; WT = (bf16_t*)(ws + W_OUT); K = 1024; N = 1024; break;
                    case 8: W = a.in[21]; gain = a.in[13] + 1024; WT = (bf16_t*)(ws + W_INO); K = 1024; N = 1024; break;
                    case 9: W = a.in[30]; WT = (bf16_t*)(ws + W_GLU); K = 1024; N = 2048; mode = 1; break;
                    case 10: W = a.in[33]; gain = a.in[31]; WT = (bf16_t*)(ws + W_XQ); K = 1024; N = 1024; break;
                    case 11: W = a.in[33] + 1048576; gain = a.in[31] + 1024; WT = (bf16_t*)(ws + W_XQ) + 1048576; K = 1024; N = 1024; break;
                    case 12: W = a.in[36]; WT = (bf16_t*)(ws + W_XO); K = 1024; N = 1024; break;
                    case 13: W = a.in[36] + 1048576; WT = (bf16_t*)(ws + W_XO) + 1048576; K = 1024; N = 1024; break;
                    case 14: W = a.in[34]; gain = a.in[32]; WT = (bf16_t*)(ws + W_MEM); K = 1024; N = 1024; roff = 0; break;
                    case 15: W = a.in[35]; gain = a.in[32]; WT = (bf16_t*)(ws + W_MEM); K = 1024; N = 1024; roff = 1024; break;
                    case 16: W = a.in[34] + 1048576; gain = a.in[32] + 1024; WT = (bf16_t*)(ws + W_MEM); K = 1024; N = 1024; roff = 2048; break;
                    default: W = a.in[35] + 1048576; gain = a.in[32] + 1024; WT = (bf16_t*)(ws + W_MEM); K = 1024; N = 1024; roff = 3072; break;
                }
                tr_loop(W, K, N, gain, WT, roff, mode, scr, gw, ngw, lane);
}

template <int ph, bool SECOND = false>
__device__ __forceinline__ void run_phase(const Args& a, LAS unsigned char* lds, const XcdBarrier& xbar) {
    constexpr float RMUL = SECOND ? 0.0f : 1.0f;
    const int tid = threadIdx.x, lane = tid & 63, wid = __builtin_amdgcn_readfirstlane(tid >> 6);
    const int gw = blockIdx.x * 8 + wid, ngw = gridDim.x * 8, gt = blockIdx.x * 512 + tid, ngt = gridDim.x * 512;
    unsigned char* ws = a.ws; float* out = a.out;
    bf16_t* xb = (bf16_t*)(ws + XB); float* ss = (float*)(ws + SS);
    LAS float* scr = (LAS float*)(lds + wid * 8448);
    const bool fastffn = (gridDim.x == 256);
    const int nbusy = 544 % (int)gridDim.x, tailb = (int)blockIdx.x - nbusy, gwt = tailb * 8 + wid, ngwt = ((int)gridDim.x - nbusy) * 8, gtt = tailb * 512 + tid, ngtt = ((int)gridDim.x - nbusy) * 512;

    {
        constexpr int layer = (ph >= 13 && ph != 26) ? 1 : 0;
        switch (ph) {
        case 0: if (PH_ON(0)) {
            for (int j = 0; j < 18; ++j) if (j < 2 || j >= 14) tr_weight_job(a, ws, j, scr, gw, ngw, lane);
            for (int row0 = gw; row0 < T; row0 += 4 * ngw) {
                f32x4 v[4][4]; bool ok[4];
#pragma unroll
                for (int q = 0; q < 4; ++q) { const int row = row0 + q * ngw; ok[q] = row < T; const int rr = ok[q] ? row : gw;
                    const float* src = rr < TP ? a.in[0] + (size_t)rr * DM : a.in[1] + (size_t)(rr - TP) * DM;
#pragma unroll
                    for (int j = 0; j < 4; ++j) v[q][j] = *(const f32x4*)(src + 4 * lane + 256 * j); }
#pragma unroll
                for (int q = 0; q < 4; ++q) { const int row = row0 + q * ngw; float s = 0.f;
#pragma unroll
                    for (int j = 0; j < 4; ++j) { const f32x4 w = v[q][j]; s += (w.x * w.x + w.y * w.y) + (w.z * w.z + w.w * w.w);
                        if (ok[q]) { u32x2 o; o.x = pk2(w.x, w.y); o.y = pk2(w.z, w.w); *(u32x2*)(xb + (size_t)row * DM + 4 * lane + 256 * j) = o; } }
                    s = wave_sum(s); if (ok[q] && lane < 16) ss[(size_t)row * 32 + lane] = lane == 0 ? s : 0.f; }
            }
            { bf16_t* memb = (bf16_t*)(ws + MEMB); float* ssm = (float*)(ws + SSMEM);
              for (int row = gw; row < 4096; row += ngw) { const float* src = a.in[9] + (size_t)row * DM; float s = 0.f;
#pragma unroll
                for (int j = 0; j < 4; ++j) { const f32x4 v = *(const f32x4*)(src + 4 * lane + 256 * j);
                    u32x2 o; o.x = pk2(v.x, v.y); o.y = pk2(v.z, v.w); *(u32x2*)(memb + (size_t)row * DM + 4 * lane + 256 * j) = o; s += (v.x * v.x + v.y * v.y) + (v.z * v.z + v.w * v.w); }
                s = wave_sum(s); if (lane < 16) ssm[(size_t)row * 32 + lane] = lane == 0 ? s : 0.f; } }
            { bf16_t* latall = (bf16_t*)(ws + LATALL); bf16_t* krb = (bf16_t*)(ws + KRB);
              for (int r0 = gw; r0 < 32 * 1024; r0 += 4 * ngw) {
                f32x4 v[4];
#pragma unroll
                for (int q = 0; q < 4; ++q) { const int r = min(r0 + q * ngw, 32 * 1024 - 1); v[q] = *(const f32x4*)(a.in[2] + (size_t)r * 256 + 4 * lane); }
#pragma unroll
                for (int q = 0; q < 4; ++q) { const int r = r0 + q * ngw; if (r < 32 * 1024) { const int b = r >> 10, s = r & 1023;
                    u32x2 o; o.x = pk2(v[q].x, v[q].y); o.y = pk2(v[q].z, v[q].w); *(u32x2*)(latall + (size_t)(TP + b * 1088 + s) * 256 + 4 * lane) = o; } } }
              for (int i = gt; i < 32 * 1024 * 8; i += ngt) { const int r = i >> 3, pc = i & 7, b = r >> 10, s = r & 1023; const f32x4 v = *(const f32x4*)(a.in[3] + (size_t)r * 32 + 4 * pc);
                u32x2 o; o.x = pk2(v.x, v.y); o.y = pk2(v.z, v.w); *(u32x2*)(krb + (size_t)(TP + b * 1088 + s) * 32 + 4 * pc) = o; } }
        } break;
        case 1: case 11: case 13: case 23: if (PH_ON(1)) {
            const bool second = (ph == 11 || ph == 23);
            if (ph == 1) {
                pg8::Gemm g{(const bf16_t*)(ws + MEMB), (const bf16_t*)(ws + W_MEM), 1024, 1024, 1024, 16, 16, 1, 0, 0};
                pg8::EpiMemKV E{out, (const float*)(ws + SSMEM)}; pg8::gemm_phase(lds, g, E);
            }
            if (fastffn) {
                pg8::EpiSwiglu E{(bf16_t*)(ws + HBUF), ss, 16};
                { pg8::Gemm g{xb, (const bf16_t*)(ws + (second ? W_GU_B : W_GU_A)), 1024, 1024, 1024, 136, 22, 1, 0, 0, 0, 0, 1}; pg8::gemm_phase(lds, g, E); }
                xcd_barrier(xbar);
                { pg8::Gemm g{xb, (const bf16_t*)(ws + (second ? W_GU_B : W_GU_A)), 1024, 1024, 1024, 136, 22, 1, 0, 0, 0, 0, 2}; pg8::gemm_phase(lds, g, E); }
                { pg8::Gemm g{(const bf16_t*)(ws + HBUF), (const bf16_t*)(ws + (second ? W_DN_B : W_DN_A)), FF, FF, FF, 136, 4, 1, 0, 0, 0, 0, 3};
                  pg8::EpiResid Ed{xb, ss, 0.5f * RMUL}; pg8::gemm_phase(lds, g, Ed); }
            } else {
                pg8::Gemm g{xb, (const bf16_t*)(ws + (second ? W_GU_B : W_GU_A)), 1024, 1024, 1024, 136, 22, 1, 0, 0};
                pg8::EpiSwiglu E{(bf16_t*)(ws + HBUF), ss, 16}; pg8::gemm_phase(lds, g, E);
            }
        } break;
        case 2: case 12: case 14: case 24: if (PH_ON(2)) {
            const bool second = (ph == 12 || ph == 24);
            pg8::Gemm g{(const bf16_t*)(ws + HBUF), (const bf16_t*)(ws + (second ? W_DN_B : W_DN_A)), FF, FF, FF, fastffn ? 128 : 136, 4, 1, 0, 0};
            pg8::EpiResid E{xb, ss, 0.5f * RMUL}; pg8::gemm_phase(lds, g, E);
            const bool dojobs = fastffn || tailb >= 0; const int jw = fastffn ? gw : gwt, jnw = fastffn ? ngw : ngwt, jt = fastffn ? gt : gtt, jnt = fastffn ? ngt : ngtt;
            if (ph == 2 && !SECOND && dojobs) {
                __syncthreads();
                tr_weight_job(a, ws, 4, scr, jw, jnw, lane); tr_weight_job(a, ws, 5, scr, jw, jnw, lane); tr_weight_job(a, ws, 6, scr, jw, jnw, lane); tr_weight_job(a, ws, 7, scr, jw, jnw, lane);
            }
        } break;
        case 3: if (PH_ON(3)) {
            pg8::Gemm g{xb, (const bf16_t*)(ws + W_INE), 1024, 1024, 1024, 136, 9, 1, 0, 0};
            pg8::EpiBf<true> E{(bf16_t*)(ws + EVB), EV_LD, ss, 16, 1.0f}; pg8::gemm_phase(lds, g, E);
        } break;
        case 4: if (PH_ON(4)) {
            const bf16_t* evb = (const bf16_t*)(ws + EVB); bf16_t* cqn = (bf16_t*)(ws + CQN); bf16_t* latall = (bf16_t*)(ws + LATALL); bf16_t* krb = (bf16_t*)(ws + KRB); bf16_t* mixcat = (bf16_t*)(ws + MIXCAT);
            const float* qn = a.in[15]; const float* kvn = a.in[16]; const float* cw = a.in[19];
            for (int t = gw; t < T; t += ngw) {
                const bf16_t* ev = evb + (size_t)t * EV_LD; int s, S, kvrow; float pos; float* lat_o; float* kr_o; float* cv_o; const float* past = nullptr;
                if (t < TP) { const int b = t >> 11; s = t & 2047; S = 2048; pos = (float)s; kvrow = t; lat_o = out + O_LATP + (size_t)t * 256; kr_o = out + O_KRP + (size_t)t * 32; cv_o = out + O_CONVP + b * 1024; }
                else { const int ts = t - TP, b = ts >> 6; s = ts & 63; S = 64; pos = (float)(1024 + s); kvrow = TP + b * 1088 + 1024 + s; lat_o = out + O_LATS + (size_t)ts * 256; kr_o = out + O_KRS + (size_t)ts * 32; cv_o = out + O_CONVS + b * 1024; past = a.in[4] + b * 1024; }
                const bf16_t* e1 = ev - (s >= 1 ? EV_LD : 0); const bf16_t* e2 = ev - (s >= 2 ? 2 * EV_LD : 0);
                const u32x2 w_cq = *(const u32x2*)(ev + 4 * lane), w_ckv = *(const u32x2*)(ev + 256 + 4 * lane);
                const unsigned short kr1 = ev[512 + (lane & 15)], kr2 = ev[528 + (lane & 15)];
                const u32x4 gc0 = *(const u32x4*)(ev + 1056 + 8 * lane), vi0 = *(const u32x4*)(ev + 1568 + 8 * lane), gb0 = *(const u32x4*)(ev + 544 + 8 * lane);
                const u32x4 gc1 = *(const u32x4*)(e1 + 1056 + 8 * lane), vi1 = *(const u32x4*)(e1 + 1568 + 8 * lane), gc2 = *(const u32x4*)(e2 + 1056 + 8 * lane), vi2 = *(const u32x4*)(e2 + 1568 + 8 * lane);
                const f32x4 gq = *(const f32x4*)(qn + 4 * lane), gk = *(const f32x4*)(kvn + 4 * lane);
                const f32x4 cw0a = *(const f32x4*)(cw + 8 * lane), cw0b = *(const f32x4*)(cw + 8 * lane + 4), cw1a = *(const f32x4*)(cw + 512 + 8 * lane), cw1b = *(const f32x4*)(cw + 512 + 8 * lane + 4), cw2a = *(const f32x4*)(cw + 1024 + 8 * lane), cw2b = *(const f32x4*)(cw + 1024 + 8 * lane + 4);
                { const u32x2 w = w_cq; const float c0 = bf_lo(w.x), c1 = bf_hi(w.x), c2 = bf_lo(w.y), c3 = bf_hi(w.y);
                  const float rs = rsqrtf(wave_sum((c0 * c0 + c1 * c1) + (c2 * c2 + c3 * c3)) * (1.0f / 256.0f) + EPS);
                  u32x2 o; o.x = pk2(c0 * rs * gq.x, c1 * rs * gq.y); o.y = pk2(c2 * rs * gq.z, c3 * rs * gq.w); *(u32x2*)(cqn + (size_t)t * 256 + 4 * lane) = o; }
                { const u32x2 w = w_ckv; const float c0 = bf_lo(w.x), c1 = bf_hi(w.x), c2 = bf_lo(w.y), c3 = bf_hi(w.y);
                  const float rs = rsqrtf(wave_sum((c0 * c0 + c1 * c1) + (c2 * c2 + c3 * c3)) * (1.0f / 256.0f) + EPS);
                  f32x4 lv; lv.x = c0 * rs * gk.x; lv.y = c1 * rs * gk.y; lv.z = c2 * rs * gk.z; lv.w = c3 * rs * gk.w; *(f32x4*)(lat_o + 4 * lane) = lv;
                  u32x2 o; o.x = pk2(lv.x, lv.y); o.y = pk2(lv.z, lv.w); *(u32x2*)(latall + (size_t)kvrow * 256 + 4 * lane) = o; }
                if (lane < 16) { const float x1 = bf2f(kr1), x2 = bf2f(kr2); float cs, sn; cis_turns(pos * rope_ift(lane), cs, sn);
                  const float o1 = x1 * cs - x2 * sn, o2 = x1 * sn + x2 * cs; kr_o[lane] = o1; kr_o[16 + lane] = o2; krb[(size_t)kvrow * 32 + lane] = f2bf(o1); krb[(size_t)kvrow * 32 + 16 + lane] = f2bf(o2); }
                {
                    float u0[8], u1[8], u2[8], gb[8];
                    { const u32x4 gc = gc0, vi = vi0, g_ = gb0;
                      u0[0] = bf_lo(gc.x) * bf_lo(vi.x); u0[1] = bf_hi(gc.x) * bf_hi(vi.x); u0[2] = bf_lo(gc.y) * bf_lo(vi.y); u0[3] = bf_hi(gc.y) * bf_hi(vi.y);
                      u0[4] = bf_lo(gc.z) * bf_lo(vi.z); u0[5] = bf_hi(gc.z) * bf_hi(vi.z); u0[6] = bf_lo(gc.w) * bf_lo(vi.w); u0[7] = bf_hi(gc.w) * bf_hi(vi.w);
                      gb[0] = bf_lo(g_.x); gb[1] = bf_hi(g_.x); gb[2] = bf_lo(g_.y); gb[3] = bf_hi(g_.y); gb[4] = bf_lo(g_.z); gb[5] = bf_hi(g_.z); gb[6] = bf_lo(g_.w); gb[7] = bf_hi(g_.w); }
                    if (s >= 1) { const u32x4 gc = gc1, vi = vi1;
                      u1[0] = bf_lo(gc.x) * bf_lo(vi.x); u1[1] = bf_hi(gc.x) * bf_hi(vi.x); u1[2] = bf_lo(gc.y) * bf_lo(vi.y); u1[3] = bf_hi(gc.y) * bf_hi(vi.y);
                      u1[4] = bf_lo(gc.z) * bf_lo(vi.z); u1[5] = bf_hi(gc.z) * bf_hi(vi.z); u1[6] = bf_lo(gc.w) * bf_lo(vi.w); u1[7] = bf_hi(gc.w) * bf_hi(vi.w); }
                    else if (past) { const f32x4 p0 = *(const f32x4*)(past + 512 + 8 * lane), p1 = *(const f32x4*)(past + 512 + 8 * lane + 4); u1[0] = p0.x; u1[1] = p0.y; u1[2] = p0.z; u1[3] = p0.w; u1[4] = p1.x; u1[5] = p1.y; u1[6] = p1.z; u1[7] = p1.w; }
                    else {
#pragma unroll
                        for (int j = 0; j < 8; ++j) u1[j] = 0.f; }
                    if (s >= 2) { const u32x4 gc = gc2, vi = vi2;
                      u2[0] = bf_lo(gc.x) * bf_lo(vi.x); u2[1] = bf_hi(gc.x) * bf_hi(vi.x); u2[2] = bf_lo(gc.y) * bf_lo(vi.y); u2[3] = bf_hi(gc.y) * bf_hi(vi.y);
                      u2[4] = bf_lo(gc.z) * bf_lo(vi.z); u2[5] = bf_hi(gc.z) * bf_hi(vi.z); u2[6] = bf_lo(gc.w) * bf_lo(vi.w); u2[7] = bf_hi(gc.w) * bf_hi(vi.w); }
                    else if (past) { const float* pp = past + s * 512 + 8 * lane; const f32x4 p0 = *(const f32x4*)pp, p1 = *(const f32x4*)(pp + 4); u2[0] = p0.x; u2[1] = p0.y; u2[2] = p0.z; u2[3] = p0.w; u2[4] = p1.x; u2[5] = p1.y; u2[6] = p1.z; u2[7] = p1.w; }
                    else {
#pragma unroll
                        for (int j = 0; j < 8; ++j) u2[j] = 0.f; }
                    float z[8];
#pragma unroll
                    for (int j = 0; j < 8; ++j) { const float k0 = j < 4 ? cw0a[j & 3] : cw0b[j & 3], k1 = j < 4 ? cw1a[j & 3] : cw1b[j & 3], k2 = j < 4 ? cw2a[j & 3] : cw2b[j & 3]; z[j] = gb[j] * (k0 * u2[j] + k1 * u1[j] + k2 * u0[j]); }
                    u32x4 o; o.x = pk2(z[0], z[1]); o.y = pk2(z[2], z[3]); o.z = pk2(z[4], z[5]); o.w = pk2(z[6], z[7]); *(u32x4*)(mixcat + (size_t)t * DM + 512 + 8 * lane) = o;
                    if (s >= S - 2) { float* cp_ = cv_o + (s - (S - 2)) * 512 + 8 * lane; *(f32x4*)cp_ = (f32x4){u0[0], u0[1], u0[2], u0[3]}; *(f32x4*)(cp_ + 4) = (f32x4){u0[4], u0[5], u0[6], u0[7]}; }
                }
            }
        } break;
        case 5: if (PH_ON(5)) {
            { pg8::Gemm g{(const bf16_t*)(ws + CQN), (const bf16_t*)(ws + W_UQ), 256, 256, 256, 136, 3, 1, 0, 0};
              pg8::EpiBf<false> E{(bf16_t*)(ws + QB), 768, nullptr, 16, 1.44269504f * 0.10206207f}; pg8::gemm_phase(lds, g, E); }
            { pg8::Gemm g{(const bf16_t*)(ws + LATALL), (const bf16_t*)(ws + W_UKV), 256, 256, 256, 264, 4, 1, 0, 0, 0, 0, 0, 104};
              pg8::EpiBf<false> E{(bf16_t*)(ws + KVB), 1024, nullptr, 16, 1.0f}; pg8::gemm_phase(lds, g, E); }
        } break;
        case 6: if (PH_ON(6)) {
            attn_phase<0>(lds, (const bf16_t*)(ws + QB), (const bf16_t*)(ws + KVB), (const bf16_t*)(ws + KRB), nullptr, nullptr, (bf16_t*)(ws + MIXCAT));
        } break;
        case 7: if (PH_ON(7)) {
            pg8::Gemm g{(const bf16_t*)(ws + MIXCAT), (const bf16_t*)(ws + W_OUT), 1024, 1024, 1024, 136, 4, 1, 0, 0};
            pg8::EpiResid E{xb, ss, 1.0f * RMUL}; pg8::gemm_phase(lds, g, E);
            if (!SECOND && tailb >= 0) {
                __syncthreads();
                if (!fastffn) {
                tr_loop(a.in[11] + (size_t)1024 * 5632, 1024, 5632, a.in[10] + 1024, (bf16_t*)(ws + W_GU_A), 0, 1, scr, gwt, ngwt, lane);
                tr_loop(a.in[12] + (size_t)2816 * 1024, 2816, 1024, nullptr, (bf16_t*)(ws + W_DN_A), 0, 0, scr, gwt, ngwt, lane);
                } else {
                for (int j = 2; j < 14; ++j) if (j < 4 || j >= 8) tr_weight_job(a, ws, j, scr, gwt, ngwt, lane);
            {
                float* klag = (float*)(ws + KLAG);
                for (int idx = gtt; idx < 65536; idx += ngtt) { const int g = idx >> 10, d = (idx >> 4) & 63, cp = idx & 15; const float dt = __expf(a.in[28][g]);
                    float accv[16];
#pragma unroll
                    for (int c = 0; c < 16; ++c) accv[c] = 0.f;
                    for (int p = 0; p < 64; ++p) { const float are = a.in[22][g * 64 + p], aim = a.in[23][g * 64 + p]; float abr, abi; cpow(are, aim, dt, 1.f, abr, abi);
                        const float nr = abr - 1.f, ni = abi, den = 1.0f / (are * are + aim * aim), fr_ = (nr * are + ni * aim) * den, fi = (ni * are - nr * aim) * den;
                        const float bre = a.in[24][(g * 64 + p) * 16 + cp], bim = a.in[25][(g * 64 + p) * 16 + cp], bbr = fr_ * bre - fi * bim, bbi = fr_ * bim + fi * bre;
                        float pr, pi; cpow(are, aim, dt, (float)d, pr, pi); const float wr_ = pr * bbr - pi * bbi, wi = pr * bbi + pi * bbr;
#pragma unroll
                        for (int c = 0; c < 16; ++c) accv[c] += a.in[26][(g * 16 + c) * 64 + p] * wr_ - a.in[27][(g * 16 + c) * 64 + p] * wi; }
#pragma unroll
                    for (int c = 0; c < 16; ++c) klag[((size_t)(g * 64 + d) * 16 + c) * 16 + cp] = accv[c]; }
            }
                }
            }
        } break;
        case 8: case 20: if (PH_ON(8)) {
            pg8::Gemm g{xb, (const bf16_t*)(ws + W_XQ) + (size_t)layer * 1048576, 1024, 1024, 1024, 136, 4, 1, 0, 0};
            pg8::EpiBf<true> E{(bf16_t*)(ws + QX), 1024, ss, ph == 20 ? 32 : 16, 0.0625f * 1.44269504f}; pg8::gemm_phase(lds, g, E);
            if (!SECOND && tailb >= 0) {
                __syncthreads();
                bf16_t* kx = (bf16_t*)(ws + KXB); bf16_t* vx = (bf16_t*)(ws + VXT);
                for (int bg = 0; bg < 48; ++bg) { const float* vsrc = bg < 16 ? out + O_MVP + (size_t)layer * 4194304 + (size_t)bg * 262144 : a.in[8] + (size_t)layer * 8388608 + (size_t)(bg - 16) * 262144;
                    tr_loop(vsrc, 256, 1024, nullptr, vx + (size_t)bg * 262144, 0, 0, scr, gwt, ngwt, lane); }
                for (int i = gtt; i < 48 * 32768; i += ngtt) { const int bg = i >> 15, e = (i & 32767) * 8;
                    const float* ksrc = (bg < 16 ? out + O_MKP + (size_t)layer * 4194304 + (size_t)bg * 262144 : a.in[7] + (size_t)layer * 8388608 + (size_t)(bg - 16) * 262144) + e;
                    const f32x4 v0 = *(const f32x4*)ksrc, v1 = *(const f32x4*)(ksrc + 4); u32x4 o; o.x = pk2(v0.x, v0.y); o.y = pk2(v0.z, v0.w); o.z = pk2(v1.x, v1.y); o.w = pk2(v1.z, v1.w);
                    *(u32x4*)(kx + (size_t)bg * 262144 + e) = o; }
            }
        } break;
        case 9: case 21: if (PH_ON(9)) {
            attn_phase<1>(lds, (const bf16_t*)(ws + QX), nullptr, nullptr, (const bf16_t*)(ws + KXB), (const bf16_t*)(ws + VXT), (bf16_t*)(ws + ATTX));
        } break;
        case 10: case 22: if (PH_ON(10)) {
            pg8::Gemm g{(const bf16_t*)(ws + ATTX), (const bf16_t*)(ws + W_XO) + (size_t)layer * 1048576, 1024, 1024, 1024, 136, 4, 1, 0, 0};
            pg8::EpiResid E{xb, ss, 1.0f * RMUL}; pg8::gemm_phase(lds, g, E);
            if (fastffn && !SECOND && tailb >= 0) {
                __syncthreads();
                if (ph == 10) {
                tr_loop(a.in[11] + (size_t)1024 * 5632, 1024, 5632, a.in[10] + 1024, (bf16_t*)(ws + W_GU_A), 0, 1, scr, gwt, ngwt, lane);
                tr_loop(a.in[12] + (size_t)2816 * 1024, 2816, 1024, nullptr, (bf16_t*)(ws + W_DN_A), 0, 0, scr, gwt, ngwt, lane);
                bf16_t* bte = (bf16_t*)(ws + BTE);
                for (int idx = gtt; idx < 262144; idx += ngtt) { const int g = idx >> 12, p = (idx >> 6) & 63, j = idx & 63; const float dt = __expf(a.in[28][g]);
                    const float are = a.in[22][g * 64 + p], aim = a.in[23][g * 64 + p]; float abr, abi; cpow(are, aim, dt, 1.f, abr, abi);
                    const float nr = abr - 1.f, ni = abi, den = 1.0f / (are * are + aim * aim), fr_ = (nr * are + ni * aim) * den, fi = (ni * are - nr * aim) * den;
                    float pr, pi; cpow(are, aim, dt, (float)(63 - j), pr, pi); const float wr_ = pr * fr_ - pi * fi, wi = pr * fi + pi * fr_;
                    float re[16], im[16];
#pragma unroll
                    for (int c = 0; c < 16; ++c) { const float bre = a.in[24][(g * 64 + p) * 16 + c], bim = a.in[25][(g * 64 + p) * 16 + c]; re[c] = wr_ * bre - wi * bim; im[c] = wr_ * bim + wi * bre; }
                    u32x4 o; bf16_t* d0 = bte + ((size_t)(g * 128 + p) * 1024 + j * 16); bf16_t* d1 = bte + ((size_t)(g * 128 + 64 + p) * 1024 + j * 16);
                    o.x = pk2(re[0], re[1]); o.y = pk2(re[2], re[3]); o.z = pk2(re[4], re[5]); o.w = pk2(re[6], re[7]); *(u32x4*)d0 = o;
                    o.x = pk2(re[8], re[9]); o.y = pk2(re[10], re[11]); o.z = pk2(re[12], re[13]); o.w = pk2(re[14], re[15]); *(u32x4*)(d0 + 8) = o;
                    o.x = pk2(im[0], im[1]); o.y = pk2(im[2], im[3]); o.z = pk2(im[4], im[5]); o.w = pk2(im[6], im[7]); *(u32x4*)d1 = o;
                    o.x = pk2(im[8], im[9]); o.y = pk2(im[10], im[11]); o.z = pk2(im[12], im[13]); o.w = pk2(im[14], im[15]); *(u32x4*)(d1 + 8) = o; }
                } else {
                tr_loop(a.in[38] + (size_t)1024 * 5632, 1024, 5632, a.in[37] + 1024, (bf16_t*)(ws + W_GU_B), 0, 1, scr, gwt, ngwt, lane);
                tr_loop(a.in[39] + (size_t)2816 * 1024, 2816, 1024, nullptr, (bf16_t*)(ws + W_DN_B), 0, 0, scr, gwt, ngwt, lane);
                }
            }
        } break;
        case 15: if (PH_ON(15)) {
            pg8::Gemm g{xb, (const bf16_t*)(ws + W_INO), 1024, 1024, 1024, 136, 4, 1, 0, 0};
            pg8::EpiU E{(bf16_t*)(ws + UPACK), ss, 16}; pg8::gemm_phase(lds, g, E);
            if (fastffn && !SECOND && tailb >= 0) {
                __syncthreads();
                const float* klag = (const float*)(ws + KLAG); bf16_t* bty = (bf16_t*)(ws + BTY);
                for (int r = gwt; r < 65536; r += ngwt) { const int g = r >> 10, n = r & 1023, l = n >> 4, c = n & 15; bf16_t* dst = bty + (size_t)r * UP_LD;
                    u32x4 o0 = {0u, 0u, 0u, 0u}, o1 = {0u, 0u, 0u, 0u};
                    if (lane <= l) { const float* kp_ = klag + ((size_t)(g * 64 + (l - lane)) * 16 + c) * 16; const f32x4 k0 = *(const f32x4*)kp_, k1 = *(const f32x4*)(kp_ + 4), k2 = *(const f32x4*)(kp_ + 8), k3 = *(const f32x4*)(kp_ + 12);
                        o0.x = pk2(k0.x, k0.y); o0.y = pk2(k0.z, k0.w); o0.z = pk2(k1.x, k1.y); o0.w = pk2(k1.z, k1.w); o1.x = pk2(k2.x, k2.y); o1.y = pk2(k2.z, k2.w); o1.z = pk2(k3.x, k3.y); o1.w = pk2(k3.z, k3.w); }
                    if (lane < 16 * ((l >> 4) + 1)) { *(u32x4*)(dst + 128 + lane * 16) = o0; *(u32x4*)(dst + 128 + lane * 16 + 8) = o1; }
                    const float dt = __expf(a.in[28][g]); float pr, pi; cpow(a.in[22][g * 64 + lane], a.in[23][g * 64 + lane], dt, (float)(l + 1), pr, pi);
                    const float cr = a.in[26][(g * 16 + c) * 64 + lane], ci = a.in[27][(g * 16 + c) * 64 + lane];
                    dst[lane] = f2bf(cr * pr - ci * pi); dst[64 + lane] = f2bf(-(cr * pi + ci * pr)); }
            }
        } break;
        case 16: if (PH_ON(16)) {
            pg8::Gemm g{(const bf16_t*)(ws + UPACK) + 128, (const bf16_t*)(ws + BTE), UP_LD, 1024, 1024, 3, 1, 64, (long)NCH * UP_LD, (long)128 * 1024};
            pg8::EpiE E{(float*)(ws + EBUF)}; pg8::gemm_phase(lds, g, E);
        } break;
        case 17: if (PH_ON(17)) {
            const float* eb = (const float*)(ws + EBUF); bf16_t* up = (bf16_t*)(ws + UPACK);
            for (int idx = gt; idx < 48 * 4096; idx += ngt) { const int bg = idx >> 12, g = (idx >> 6) & 63, p = idx & 63; const float dt = __expf(a.in[28][g]);
                float ar, ai; cpow(a.in[22][g * 64 + p], a.in[23][g * 64 + p], dt, 64.f, ar, ai);
                float hr = 0.f, hi = 0.f; int chunk0, n; float* o_re; float* o_im;
                if (bg < 16) { chunk0 = bg * 32; n = 32; o_re = out + O_SREP + (size_t)(bg * 64 + g) * 64 + p; o_im = out + O_SIMP + (size_t)(bg * 64 + g) * 64 + p; }
                else { const int bs = bg - 16; chunk0 = 512 + bs; n = 1; hr = a.in[5][(size_t)(bs * 64 + g) * 64 + p]; hi = a.in[6][(size_t)(bs * 64 + g) * 64 + p]; o_re = out + O_SRES + (size_t)(bs * 64 + g) * 64 + p; o_im = out + O_SIMS + (size_t)(bs * 64 + g) * 64 + p; }
                if (n == 32) {
                    for (int c0 = 0; c0 < 32; c0 += 8) { float er[8], ei[8];
#pragma unroll
                        for (int c = 0; c < 8; ++c) { const size_t r = (size_t)g * NCH + chunk0 + c0 + c; er[c] = eb[r * 128 + p]; ei[c] = eb[r * 128 + 64 + p]; }
#pragma unroll
                        for (int c = 0; c < 8; ++c) { const size_t r = (size_t)g * NCH + chunk0 + c0 + c; up[r * UP_LD + p] = f2bf(hr); up[r * UP_LD + 64 + p] = f2bf(hi);
                            const float nr = ar * hr - ai * hi + er[c], ni = ar * hi + ai * hr + ei[c]; hr = nr; hi = ni; } }
                } else { const size_t r = (size_t)g * NCH + chunk0; up[r * UP_LD + p] = f2bf(hr); up[r * UP_LD + 64 + p] = f2bf(hi);
                    const float er = eb[r * 128 + p], ei = eb[r * 128 + 64 + p]; const float nr = ar * hr - ai * hi + er, ni = ar * hi + ai * hr + ei; hr = nr; hi = ni; }
                *o_re = hr; *o_im = hi; }
        } break;
        case 18: if (PH_ON(18)) {
            pg8::Gemm g{(const bf16_t*)(ws + UPACK), (const bf16_t*)(ws + BTY), UP_LD, UP_LD, UP_LD, 3, 4, 64, (long)NCH * UP_LD, (long)1024 * UP_LD, 1};
            pg8::EpiY E{(bf16_t*)(ws + YBUF), (const bf16_t*)(ws + UPACK), a.in[29]}; pg8::gemm_phase(lds, g, E);
        } break;
        case 19: if (PH_ON(19)) {
            pg8::Gemm g{(const bf16_t*)(ws + YBUF), (const bf16_t*)(ws + W_GLU), 16, 1024, 1024, 136, 8, 1, (long)T * 16, 0, 0, 1};
            pg8::EpiGluResid E{xb, ss, RMUL}; pg8::gemm_phase(lds, g, E);
        } break;
        default: if (PH_ON(25)) {
            const float* gf = a.in[40];
            for (int row0 = gw; row0 < T; row0 += 4 * ngw) {
                u32x2 xw[4][4]; bool ok[4];
#pragma unroll
                for (int q = 0; q < 4; ++q) { const int row = row0 + q * ngw; ok[q] = row < T; const int rr = ok[q] ? row : gw;
#pragma unroll
                    for (int j = 0; j < 4; ++j) xw[q][j] = *(const u32x2*)(xb + (size_t)rr * DM + 4 * lane + 256 * j); }
#pragma unroll
                for (int q = 0; q < 4; ++q) { const int row = row0 + q * ngw; float* p = out + O_Y + (size_t)row * DM; f32x4 v[4]; float s = 0.f;
#pragma unroll
                    for (int j = 0; j < 4; ++j) { const u32x2 w = xw[q][j]; v[j] = (f32x4){bf_lo(w.x), bf_hi(w.x), bf_lo(w.y), bf_hi(w.y)};
                        s += (v[j].x * v[j].x + v[j].y * v[j].y) + (v[j].z * v[j].z + v[j].w * v[j].w); }
                    const float rs = rsqrtf(wave_sum(s) * (1.0f / 1024.0f) + EPS);
                    if (ok[q]) {
#pragma unroll
                        for (int j = 0; j < 4; ++j) { const f32x4 gg = *(const f32x4*)(gf + 4 * lane + 256 * j); *(f32x4*)(p + 4 * lane + 256 * j) = v[j] * rs * gg; } } }
            }
        } break;
        }
    }
}

__global__ void __launch_bounds__(512, 2) mk(Args a) {
    extern __shared__ __attribute__((aligned(16))) unsigned char shm[];
    LAS unsigned char* lds = (LAS unsigned char*)shm;
    const int lo = a.ph_lo, hi = a.ph_hi;
    volatile LAS unsigned* bst = (volatile LAS unsigned*)(lds + LDS_BYTES);
    if (threadIdx.x == 0) { bst[0] = 0u; bst[1] = 0u; bst[2] = 0u; bst[3] = 0u; }
    __syncthreads();
    XcdBarrier xbar; xbar.bar = (unsigned*)(a.ws + WS_BAR); xbar.x = 0; xbar.st = bst;
    if (hi - lo > 1) xbar = xcd_barrier_post((unsigned*)(a.ws + WS_BAR), bst);
    if (lo > 1000) cg::this_grid().sync();
#define STEP(p, k) if (lo <= (p) && (p) < hi) { run_phase<k>(a, lds, xbar); if (((DBLMASK) >> (k)) & 1u) { __syncthreads(); run_phase<k, true>(a, lds, xbar); } } if (lo <= (p) && (p) + 1 < hi) xcd_barrier(xbar);
    STEP(0, 0) STEP(1, 1) STEP(2, 2) STEP(3, 3) STEP(4, 4) STEP(5, 5) STEP(6, 6) STEP(7, 7) STEP(8, 8) STEP(9, 9) STEP(10, 10) STEP(11, 11) STEP(12, 12) STEP(13, 13) STEP(14, 14) STEP(15, 15) STEP(16, 16) STEP(17, 17) STEP(18, 18) STEP(19, 19) STEP(20, 20) STEP(21, 21) STEP(22, 22) STEP(23, 23) STEP(24, 24) STEP(25, 25)
#undef STEP
}


extern "C" void kernel_launch(void* const* d_in, const int* in_sizes, int n_in, void* d_out, int out_size, void* d_ws, size_t ws_size, hipStream_t stream) {
    static int grid = 0;
    if (grid == 0) {
        if (n_in != 41 || (size_t)out_size != O_END || ws_size < WS_END) { fprintf(stderr, "kernel_launch: unexpected shapes: n_in %d out %d ws %zu (need %zu)\n", n_in, out_size, ws_size, (size_t)WS_END); grid = -1; return; }
        int dev = 0, cus = 0, per_cu = 0;
        hipGetDevice(&dev); hipDeviceGetAttribute(&cus, hipDeviceAttributeMultiprocessorCount, dev);
        if (hipFuncSetAttribute((const void*)mk, hipFuncAttributeMaxDynamicSharedMemorySize, LDS_BYTES + 16) != hipSuccess) { fprintf(stderr, "kernel_launch: hipFuncSetAttribute failed\n"); grid = -1; return; }
        if (hipOccupancyMaxActiveBlocksPerMultiprocessor(&per_cu, (const void*)mk, 512, LDS_BYTES + 16) != hipSuccess || per_cu < 1) { fprintf(stderr, "kernel_launch: occupancy query says %d\n", per_cu); per_cu = 1; }
        (void)hipGetLastError();
        grid = cus * per_cu;
        if (grid != 256) { fprintf(stderr, "kernel_launch: this build's phase schedule is laid out for 256 co-resident workgroups (one per CU of a 256-CU device); got %d; nothing launched\n", grid); grid = -1; return; }
    }
    if (grid < 0) return;
    if (hipMemsetAsync((char*)d_ws + WS_BAR, 0, XCD_BAR_BYTES, stream) != hipSuccess) { fprintf(stderr, "kernel_launch: memset of the barrier words failed\n"); return; }
    Args a{};
    for (int i = 0; i < 41; ++i) a.in[i] = (const float*)d_in[i];
    a.out = (float*)d_out; a.ws = (unsigned char*)d_ws;
#if MK_PER_PHASE
    for (int ph = 0; ph < NPHASE; ++ph) { a.ph_lo = ph; a.ph_hi = ph + 1; hipLaunchKernelGGL(mk, dim3(grid), dim3(512), LDS_BYTES + 16, stream, a); }
#else
    a.ph_lo = 0; a.ph_hi = NPHASE;
    void* args[] = {&a};
    hipError_t e = hipLaunchCooperativeKernel((const void*)mk, dim3(grid), dim3(512), args, LDS_BYTES + 16, stream);
    if (e != hipSuccess) fprintf(stderr, "cooperative launch failed: %s (grid %d)\n", hipGetErrorString(e), grid);
#endif
}
```

```cpp
#include <hip/hip_runtime.h>
#include <hip/hip_cooperative_groups.h>
#include <cstdio>
#include <cstdint>
namespace cg = cooperative_groups;

#ifndef MK_PER_PHASE
#define MK_PER_PHASE 0
#endif

#ifndef DBLMASK
#define DBLMASK 0u
#endif
#ifndef PHMASK
#define PHMASK 0xffffffffu
#endif
#define PH_ON(k) (((PHMASK) >> (k)) & 1u)
#define LAS __attribute__((address_space(3)))
typedef unsigned short bf16_t;
typedef short bf16x8 __attribute__((ext_vector_type(8)));
typedef short bf16x4 __attribute__((ext_vector_type(4)));
typedef float f32x4 __attribute__((ext_vector_type(4)));
typedef unsigned u32x4 __attribute__((ext_vector_type(4)));
typedef unsigned u32x2 __attribute__((ext_vector_type(2)));

constexpr int T = 34816, TP = 32768, DM = 1024, FF = 2816, KVROWS = 67584, NCH = 544, UP_LD = 1152, EV_LD = 2304;
constexpr float EPS = 1e-6f;
constexpr int NPHASE = 26;
constexpr size_t XCD_BAR_BYTES = 3456 * 4;
constexpr size_t O_Y = 0, O_LATP = 35651584, O_KRP = O_LATP + 8388608, O_CONVP = O_KRP + 1048576, O_SREP = O_CONVP + 16384, O_SIMP = O_SREP + 65536,
                 O_MKP = O_SIMP + 65536, O_MVP = O_MKP + 8388608, O_LATS = O_MVP + 8388608, O_KRS = O_LATS + 524288, O_CONVS = O_KRS + 65536,
                 O_SRES = O_CONVS + 32768, O_SIMS = O_SRES + 131072, O_END = O_SIMS + 131072;
constexpr size_t al(size_t x) { return (x + 255) & ~(size_t)255; }
constexpr size_t W_GU_A = 0, SZ_GU = (size_t)5632 * 1024 * 2, W_DN_A = W_GU_A + SZ_GU, SZ_DN = (size_t)1024 * 2816 * 2, W_GU_B = W_DN_A + SZ_DN, W_DN_B = W_GU_B + SZ_GU,
                 W_INE = W_DN_B + SZ_DN, W_UQ = W_INE + (size_t)2304 * 1024 * 2, W_UKV = W_UQ + (size_t)768 * 256 * 2, W_OUT = W_UKV + (size_t)1024 * 256 * 2,
                 W_INO = W_OUT + (size_t)1024 * 1024 * 2, W_GLU = W_INO + (size_t)1024 * 1024 * 2, W_XQ = W_GLU + (size_t)2048 * 1024 * 2, W_XO = W_XQ + (size_t)2 * 1024 * 1024 * 2,
                 W_MEM = W_XO + (size_t)2 * 1024 * 1024 * 2, XB = W_MEM + (size_t)4096 * 1024 * 2, SS = XB + (size_t)T * 1024 * 2, SSMEM = SS + (size_t)T * 32 * 4,
                 KLAG = SSMEM + (size_t)4096 * 32 * 4, BIG = KLAG + (size_t)64 * 64 * 256 * 4;
constexpr size_t HBUF = BIG, SZ_HBUF = (size_t)T * FF * 2;
constexpr size_t EVB = BIG, KVB = BIG, CQN = BIG + (size_t)T * EV_LD * 2, LATALL = BIG + SZ_HBUF, KRB = LATALL + (size_t)KVROWS * 256 * 2, QB = KRB + (size_t)KVROWS * 32 * 2,
                 MEMB = QB, MIXCAT = QB + (size_t)T * 768 * 2;
constexpr size_t QX = BIG, ATTX = BIG + (size_t)T * 1024 * 2, KXB = ATTX + (size_t)T * 1024 * 2, VXT = KXB + (size_t)48 * 262144 * 2;
constexpr size_t UPACK = BIG, YBUF = al(BIG + (size_t)64 * NCH * UP_LD * 2), EBUF = YBUF + (size_t)T * 1024 * 2, BTY = BIG + SZ_HBUF, BTE = BTY + (size_t)64 * 1024 * UP_LD * 2;
constexpr size_t WS_BAR = BTE + (size_t)64 * 128 * 1024 * 2 + (size_t)(1 << 20), WS_END = WS_BAR + XCD_BAR_BYTES;
static_assert(CQN + (size_t)T * 256 * 2 <= BIG + SZ_HBUF, "cqn overlaps latall");
static_assert(EBUF + (size_t)64 * NCH * 128 * 4 <= BTY, "ssm bufs overlap");
static_assert(MIXCAT + (size_t)T * 1024 * 2 <= WS_END, "mixcat");

__device__ __forceinline__ unsigned pk2(float lo, float hi) { unsigned r; asm("v_cvt_pk_bf16_f32 %0, %1, %2" : "=v"(r) : "v"(lo), "v"(hi)); return r; }
__device__ __forceinline__ float bf_lo(unsigned w) { return __uint_as_float(w << 16); }
__device__ __forceinline__ float bf_hi(unsigned w) { return __uint_as_float(w & 0xffff0000u); }
__device__ __forceinline__ float bf2f(unsigned short h) { return __uint_as_float((unsigned)h << 16); }
__device__ __forceinline__ unsigned short f2bf(float f) { return (unsigned short)(pk2(f, 0.f) & 0xffffu); }
__device__ __forceinline__ float red_sum16(float x) { const auto r = __builtin_amdgcn_permlane16_swap(__float_as_uint(x), __float_as_uint(x), false, false); return __uint_as_float(r[0]) + __uint_as_float(r[1]); }
__device__ __forceinline__ float red_sum32(float x) { const auto r = __builtin_amdgcn_permlane32_swap(__float_as_uint(x), __float_as_uint(x), false, false); return __uint_as_float(r[0]) + __uint_as_float(r[1]); }
__device__ __forceinline__ float red_max16(float x) { const auto r = __builtin_amdgcn_permlane16_swap(__float_as_uint(x), __float_as_uint(x), false, false); return fmaxf(__uint_as_float(r[0]), __uint_as_float(r[1])); }
__device__ __forceinline__ float red_max32(float x) { const auto r = __builtin_amdgcn_permlane32_swap(__float_as_uint(x), __float_as_uint(x), false, false); return fmaxf(__uint_as_float(r[0]), __uint_as_float(r[1])); }
__device__ __forceinline__ float wave_sum(float v) {
#pragma unroll
    for (int o = 1; o < 16; o <<= 1) v += __shfl_xor(v, o);
    return red_sum32(red_sum16(v));
}
__device__ __forceinline__ float lane_xor32(float x, int fq) { const auto r = __builtin_amdgcn_permlane32_swap(__float_as_uint(x), __float_as_uint(x), false, false); return __uint_as_float(fq < 2 ? r[1] : r[0]); }
__device__ __forceinline__ float fast_rcp(float x) { return __builtin_amdgcn_rcpf(x); }
__device__ __forceinline__ float fast_exp(float x) { return __builtin_amdgcn_exp2f(x * 1.44269504f); }
__device__ __forceinline__ float sigmoidf_(float x) { return fast_rcp(1.0f + fast_exp(-x)); }
__device__ __forceinline__ float rope_ift(int ii) { return __builtin_amdgcn_exp2f(-(float)ii * 0.83048202f) * 0.15915494f; }
__device__ __forceinline__ void cis_turns(float t, float& c, float& s) { t = t - floorf(t); c = __builtin_amdgcn_cosf(t); s = __builtin_amdgcn_sinf(t); }
__device__ __forceinline__ void cpow(float are, float aim, float dt, float d, float& pr, float& pi) {
    const float mag = __expf(d * are * dt); float c, s; cis_turns(d * (aim * dt * 0.15915494f), c, s); pr = mag * c; pi = mag * s;
}
__device__ __forceinline__ float row_rstd(const float* ss, int row, int fq, int np) {
    float s;
    if (np == 16) { const f32x4 v = *(const f32x4*)(ss + (size_t)row * 32 + 4 * fq); s = (v.x + v.y) + (v.z + v.w); }
    else { const f32x4 v = *(const f32x4*)(ss + (size_t)row * 32 + 8 * fq), w = *(const f32x4*)(ss + (size_t)row * 32 + 8 * fq + 4); s = ((v.x + v.y) + (v.z + v.w)) + ((w.x + w.y) + (w.z + w.w)); }
    s = red_sum32(red_sum16(s));
    return __builtin_amdgcn_rsqf(s * (1.0f / 1024.0f) + EPS);
}


#define XB_TMO      128
#define XB_XCNT(j)  (256  + 64 * (j))
#define XB_XSUB(j)  (1280 + 64 * (j))
#define XB_XGEN(j)  (2304 + 64 * (j))
#define XB_TOP      3328
#define XB_TOPGEN   3392
#define XCD_BAR_WORDS 3456
#define XB_SPIN_CAP (1u << 18)
__device__ __forceinline__ unsigned xb_ld(unsigned* p)              { return __hip_atomic_load(p, __ATOMIC_RELAXED, __HIP_MEMORY_SCOPE_AGENT); }
__device__ __forceinline__ unsigned xb_add(unsigned* p, unsigned v) { return __hip_atomic_fetch_add(p, v, __ATOMIC_RELAXED, __HIP_MEMORY_SCOPE_AGENT); }
__device__ __forceinline__ unsigned xb_xcc_id() { return (unsigned)__builtin_amdgcn_s_getreg((3 << 11) | 20) & 0xFu; }
#define XB_SPIN(cond, bar) do { unsigned _sp = 0; while (cond) { __builtin_amdgcn_s_sleep(1); \
    if ((++_sp & 255u) == 0u) { if (xb_ld(&(bar)[XB_TMO])) break; if (_sp > XB_SPIN_CAP) { atomicAdd(&(bar)[XB_TMO], 1u); break; } } } } while (0)
struct XcdBarrier { unsigned* bar; unsigned x; volatile LAS unsigned* st; };
__device__ __forceinline__ XcdBarrier xcd_barrier_post(unsigned* bar, volatile LAS unsigned* st) {
    XcdBarrier b; b.bar = bar; b.x = xb_xcc_id(); b.st = st;
    if (threadIdx.x == 0) (void)xb_add(&bar[XB_XCNT(b.x)], 1u);
    return b;
}
__device__ __forceinline__ void xcd_barrier_complete(unsigned* bar, unsigned x, unsigned& nloc, unsigned& nx) {
    const unsigned G = gridDim.x * gridDim.y * gridDim.z;
    unsigned sum, cnt, mine, sp = 0u;
    for (;;) {
        sum = 0u; cnt = 0u; mine = 0u;
#pragma unroll
        for (unsigned j = 0; j < 16; ++j) { const unsigned c = xb_ld(&bar[XB_XCNT(j)]); sum += c; cnt += (c > 0u) ? 1u : 0u; mine = (j == x) ? c : mine; }
        if (sum == G) break;
        __builtin_amdgcn_s_sleep(1);
        if ((++sp & 255u) == 0u) { if (xb_ld(&bar[XB_TMO])) break; if (sp > XB_SPIN_CAP) { atomicAdd(&bar[XB_TMO], 1u); break; } }
    }
    nloc = mine > 0u ? mine : 1u; nx = cnt > 0u ? cnt : 1u;
}
__device__ __forceinline__ void xcd_barrier(const XcdBarrier& b) {
    asm volatile("s_waitcnt vmcnt(0)" ::: "memory");
    __syncthreads();
    if (threadIdx.x == 0) {
        unsigned* bar = b.bar;
        __builtin_amdgcn_s_waitcnt(0);
        unsigned nloc = b.st[0], nx = b.st[1];
        if (nloc == 0u) { xcd_barrier_complete(bar, b.x, nloc, nx); b.st[0] = nloc; b.st[1] = nx; }
        const unsigned old = xb_add(&bar[XB_XSUB(b.x)], 1u);
        const unsigned gen = old / nloc;
        if (old + 1u == (gen + 1u) * nloc) {
            __builtin_amdgcn_fence(__ATOMIC_RELEASE, "agent");
            asm volatile("s_waitcnt vmcnt(0)" ::: "memory");
            const unsigned og = xb_add(&bar[XB_TOP], 1u);
            const unsigned tg = og / nx;
            if (og + 1u == (tg + 1u) * nx) xb_add(&bar[XB_TOPGEN], 1u);
            else XB_SPIN(xb_ld(&bar[XB_TOPGEN]) == tg, bar);
            __builtin_amdgcn_fence(__ATOMIC_ACQUIRE, "agent");
            xb_add(&bar[XB_XGEN(b.x)], 1u);
            asm volatile("s_waitcnt vmcnt(0)" ::: "memory");
        } else {
            XB_SPIN(xb_ld(&bar[XB_XGEN(b.x)]) == gen, bar);
            __builtin_amdgcn_fence(__ATOMIC_ACQUIRE, "agent");
            asm volatile("s_waitcnt vmcnt(0)" ::: "memory");
        }
    }
    __syncthreads();
}

__device__ __forceinline__ void row_rstd8(const float* ss, int row0, int fq, int np, float (&rs)[2][4]) {
    float sv[2][4];
#pragma unroll
    for (int ai = 0; ai < 2; ++ai)
#pragma unroll
        for (int m = 0; m < 4; ++m) { const int row = row0 + ai * 128 + m * 16;
            if (np == 16) { const f32x4 v = *(const f32x4*)(ss + (size_t)row * 32 + 4 * fq); sv[ai][m] = (v.x + v.y) + (v.z + v.w); }
            else { const f32x4 v = *(const f32x4*)(ss + (size_t)row * 32 + 8 * fq), w = *(const f32x4*)(ss + (size_t)row * 32 + 8 * fq + 4); sv[ai][m] = ((v.x + v.y) + (v.z + v.w)) + ((w.x + w.y) + (w.z + w.w)); } }
#pragma unroll
    for (int ai = 0; ai < 2; ++ai)
#pragma unroll
        for (int m = 0; m < 4; ++m) { const float t = red_sum32(red_sum16(sv[ai][m])); rs[ai][m] = __builtin_amdgcn_rsqf(t * (1.0f / 1024.0f) + EPS); }
}

namespace pg8 {
constexpr int BM = 256, BK = 64, HALF = 128, HTB = HALF * BK * 2, STAGE_BYTES = 8 * HTB;
__device__ __forceinline__ int lds_byte(int r, int c) { const int st = (r >> 4) * 2 + (c >> 5), rr = r & 15, cc = c & 31, ob = rr * 64 + cc * 2; return st * 1024 + (ob ^ (((ob >> 9) & 1) << 5)); }
__device__ __forceinline__ void stage_rc(int b, int& R, int& C) { const int st = b / 1024, sb = b % 1024, swz = sb ^ (((sb >> 9) & 1) << 5); R = (st >> 1) * 16 + swz / 64; C = (st & 1) * 32 + (swz % 64) / 2; }
__device__ __forceinline__ int perm32(int rho) { const int n = rho >> 4, i = rho & 15; return 8 * (i >> 2) + 4 * n + (i & 3); }
struct Unit { int pm, pn, pb; };
struct Gemm { const bf16_t* A; const bf16_t* Bt; int lda, ldb, K, nM, nN, nB; long sA, sB; int tri, amode, order, rot; };
__device__ __forceinline__ void remap_tile(int wgid, int nM, int nN, int& pm, int& pn) {
    const int nwg = nM * nN;
    { const int q = nwg / 8, r = nwg % 8, xcd = wgid % 8, off = wgid / 8; wgid = (xcd < r ? xcd * (q + 1) : r * (q + 1) + (xcd - r) * q) + off; }
    const int nig = 8 * nN, gid = wgid / nig, fm = gid * 8, gsz = (nM - fm) < 8 ? (nM - fm) : 8;
    pm = fm + ((wgid % nig) % gsz); pn = (wgid % nig) / gsz;
}
__device__ __forceinline__ bool next_unit(const Gemm& g, int i, Unit& u) {
    if (g.order) {
        const int c = (int)blockIdx.x; u.pb = 0; int p = -1;
        if (g.order == 1) { if (i) return false; if (c < 176) { u.pm = 128 + c / 22; u.pn = c % 22; return true; } p = c; }
        else if (g.order == 2) {
            if (c < 176) { if (i > 10) return false; p = i * 256 + c; }
            else if (c < 208) { if (i > 10) return false; p = i < 10 ? (i + 1) * 256 + c : 10 * 256 + c + 48; }
            else if (c < 224) { if (i > 9) return false; p = (i + 1) * 256 + c; }
            else { if (i > 8) return false; p = (i + 1) * 256 + c; }
        } else { if (i || c < 224) return false; const int t = c - 224; u.pm = 128 + (t >> 2); u.pn = t & 3; return true; }
        remap_tile(p, 128, 22, u.pm, u.pn); return true;
    }
    const int nwg = g.nM * g.nN;
    if (g.nB > 1) {
        const int G8 = (int)gridDim.x >> 3, x = (int)blockIdx.x & 7, q = i * G8 + ((int)blockIdx.x >> 3), gi = q / nwg, pb = x + 8 * gi;
        if ((gridDim.x & 7) != 0 || pb >= g.nB) { if ((gridDim.x & 7) == 0) return false; }
        else { const int r = q % nwg; u.pb = pb; u.pm = r / g.nN; u.pn = (r % g.nN + (g.tri ? i : 0)) % g.nN; return true; }
    }
    const long L = (long)i * gridDim.x + (blockIdx.x + (unsigned)g.rot) % gridDim.x; if (L >= (long)nwg * g.nB) return false;
    u.pb = (int)(L / nwg); int wgid = (int)(L % nwg);
    { const int q = nwg / 8, r = nwg % 8, xcd = wgid % 8, off = wgid / 8; wgid = (xcd < r ? xcd * (q + 1) : r * (q + 1) + (xcd - r) * q) + off; }
    const int nig = 8 * g.nN, gid = wgid / nig, fm = gid * 8, gsz = (g.nM - fm) < 8 ? (g.nM - fm) : 8;
    u.pm = fm + ((wgid % nig) % gsz); u.pn = (wgid % nig) / gsz; return true;
}
template <class Epi>
__device__ __forceinline__ void gemm_phase(LAS unsigned char* lds, const Gemm g, const Epi& E) {
    const int tid = threadIdx.x, wid = __builtin_amdgcn_readfirstlane(tid >> 6), lane = tid & 63, wr = wid >> 2, wc = wid & 3, fr = lane & 15, fq = lane >> 4;
    int nt_all = g.K / BK; asm volatile("" : "+s"(nt_all));
    unsigned voffA[2], voffB[2];
#pragma unroll
    for (int i = 0; i < 2; ++i) { int R, C; stage_rc(tid * 16 + i * 8192, R, C); const int Rb = (R & ~31) + perm32(R & 31);
        voffA[i] = g.amode ? (unsigned)(((size_t)(C >> 4) * g.sA + R * 16 + (C & 15)) * 2) : (unsigned)(R * g.lda + C) * 2u; voffB[i] = (unsigned)(Rb * g.ldb + C) * 2u; }
    const size_t kstep = (size_t)(BK * 2), kstepA = g.amode ? (size_t)g.sA * 8 : kstep;
    const size_t hsA = (size_t)HALF * g.lda * 2, hsB = (size_t)HALF * g.ldb * 2;
    const unsigned ldsw = (unsigned)wid * 1024u;
    const int aoff = lds_byte(wr * 64 + fr, fq * 8), boff = lds_byte(wc * 32 + fr, fq * 8);
#define PG8_SA(b, h) (((b) * 2 + (h)) * HTB)
#define PG8_SB(b, h) ((4 + (b) * 2 + (h)) * HTB)
#define PG8_STAGE(bufoff, gbase, voff) do { _Pragma("unroll") for (int _i = 0; _i < 2; ++_i) \
        __builtin_amdgcn_global_load_lds((const unsigned*)((const char*)(gbase) + (voff)[_i]), (LAS unsigned*)(lds + (bufoff) + ldsw + _i * 8192), 16, 0, 0); } while (0)
#define PG8_LDA(dst, b, h) do { _Pragma("unroll") for (int m = 0; m < 4; ++m) _Pragma("unroll") for (int k = 0; k < 2; ++k) dst[m][k] = *(const LAS bf16x8*)(lds + PG8_SA(b, h) + aoff + m * 2048 + k * 1024); } while (0)
#define PG8_LDB(dst, b, h) do { _Pragma("unroll") for (int n = 0; n < 2; ++n) _Pragma("unroll") for (int k = 0; k < 2; ++k) dst[n][k] = *(const LAS bf16x8*)(lds + PG8_SB(b, h) + boff + n * 2048 + k * 1024); } while (0)
#define PG8_MMA(ai, bj, At, Bt) do { __builtin_amdgcn_s_setprio(1); _Pragma("unroll") for (int m = 0; m < 4; ++m) _Pragma("unroll") for (int n = 0; n < 2; ++n) _Pragma("unroll") for (int k = 0; k < 2; ++k) \
        acc[ai][bj][m][n] = __builtin_amdgcn_mfma_f32_16x16x32_bf16(Bt[n][k], At[m][k], acc[ai][bj][m][n], 0, 0, 0); __builtin_amdgcn_s_setprio(0); } while (0)
#define PG8_WAIT_V(n) asm volatile("s_waitcnt vmcnt(" #n ")" ::: "memory")
#define PG8_WAIT_L(n) asm volatile("s_waitcnt lgkmcnt(" #n ")" ::: "memory")
#define PG8_BAR __builtin_amdgcn_s_barrier()
#define PG8_SCHED __builtin_amdgcn_sched_barrier(0)
    Unit cur, nxt; int ui = 0;
    if (!next_unit(g, 0, cur)) return;
    f32x4 acc[2][2][4][2];
#pragma unroll
    for (int a = 0; a < 2; ++a)
#pragma unroll
        for (int b = 0; b < 2; ++b)
#pragma unroll
            for (int m = 0; m < 4; ++m)
#pragma unroll
                for (int n = 0; n < 2; ++n) acc[a][b][m][n] = (f32x4){0.f, 0.f, 0.f, 0.f};
    bf16x8 At[4][2], B0[2][2], B1[2][2];
    const char* cA = (const char*)g.A + ((size_t)cur.pb * g.sA + (size_t)cur.pm * BM * g.lda) * 2; const char* cB = (const char*)g.Bt + ((size_t)cur.pb * g.sB + (size_t)cur.pn * BM * g.ldb) * 2;
    PG8_STAGE(PG8_SB(0, 0), cB, voffB); PG8_STAGE(PG8_SB(0, 1), cB + hsB, voffB); PG8_STAGE(PG8_SA(0, 0), cA, voffA); PG8_STAGE(PG8_SA(0, 1), cA + hsA, voffA);
    if (wr == 1) PG8_BAR;
    PG8_WAIT_V(2); PG8_BAR;
    PG8_STAGE(PG8_SB(1, 0), cB + kstep, voffB); PG8_STAGE(PG8_SA(1, 0), cA + kstepA, voffA); PG8_STAGE(PG8_SB(1, 1), cB + hsB + kstep, voffB);
    PG8_WAIT_V(6); PG8_BAR;
    for (;;) {
        const bool has_next = next_unit(g, ui + 1, nxt);
        const char* nA = has_next ? (const char*)g.A + ((size_t)nxt.pb * g.sA + (size_t)nxt.pm * BM * g.lda) * 2 : cA;
        const char* nB = has_next ? (const char*)g.Bt + ((size_t)nxt.pb * g.sB + (size_t)nxt.pn * BM * g.ldb) * 2 : cB;
        const int nt = g.tri ? min(nt_all, 6 + 4 * cur.pn) : nt_all;
        for (int t = 0; t < nt; t += 2) {
            const bool last = (t == nt - 2);
            const char* a1 = cA + (size_t)(t + 1) * kstepA;
            const char* a2 = last ? nA : cA + (size_t)(t + 2) * kstepA; const char* b2 = last ? nB : cB + (size_t)(t + 2) * kstep;
            const char* a3 = a2 + kstepA; const char* b3 = b2 + kstep;
            PG8_LDB(B0, 0, 0); PG8_LDB(B1, 0, 1); PG8_SCHED; PG8_LDA(At, 0, 0); PG8_STAGE(PG8_SA(1, 1), a1 + hsA, voffA);
            PG8_WAIT_V(8); PG8_WAIT_L(0); PG8_BAR; PG8_MMA(0, 0, At, B0); PG8_MMA(0, 1, At, B1); PG8_BAR; PG8_SCHED;
            PG8_LDA(At, 0, 1); PG8_STAGE(PG8_SB(0, 0), b2, voffB); PG8_STAGE(PG8_SB(0, 1), b2 + hsB, voffB); PG8_STAGE(PG8_SA(0, 0), a2, voffA);
            PG8_WAIT_V(8); PG8_WAIT_L(0); PG8_BAR; PG8_MMA(1, 0, At, B0); PG8_MMA(1, 1, At, B1); PG8_BAR; PG8_SCHED;
            PG8_LDB(B0, 1, 0); PG8_LDB(B1, 1, 1); PG8_SCHED; PG8_LDA(At, 1, 0); PG8_STAGE(PG8_SA(0, 1), a2 + hsA, voffA);
            PG8_WAIT_V(8); PG8_WAIT_L(0); PG8_BAR; PG8_MMA(0, 0, At, B0); PG8_MMA(0, 1, At, B1); PG8_BAR; PG8_SCHED;
            PG8_LDA(At, 1, 1); PG8_STAGE(PG8_SB(1, 0), b3, voffB); PG8_STAGE(PG8_SB(1, 1), b3 + hsB, voffB); PG8_STAGE(PG8_SA(1, 0), a3, voffA);
            PG8_WAIT_V(8); PG8_WAIT_L(0); PG8_BAR; PG8_MMA(1, 0, At, B0); PG8_MMA(1, 1, At, B1); PG8_BAR; PG8_SCHED;
        }
        if (wr == 0) PG8_BAR;
        E(acc, cur, wr, wc, fr, fq);
        if (!has_next) break;
#pragma unroll
        for (int a = 0; a < 2; ++a)
#pragma unroll
            for (int b = 0; b < 2; ++b)
#pragma unroll
                for (int m = 0; m < 4; ++m)
#pragma unroll
                    for (int n = 0; n < 2; ++n) acc[a][b][m][n] = (f32x4){0.f, 0.f, 0.f, 0.f};
        cur = nxt; cA = nA; cB = nB; ++ui;
        if (wr == 1) PG8_BAR;
    }
    PG8_WAIT_V(0);
    PG8_BAR;
#undef PG8_SA
#undef PG8_SB
#undef PG8_STAGE
#undef PG8_LDA
#undef PG8_LDB
#undef PG8_MMA
#undef PG8_WAIT_V
#undef PG8_WAIT_L
#undef PG8_BAR
#undef PG8_SCHED
}
typedef f32x4 Acc[2][2][4][2];

struct EpiSwiglu { bf16_t* H; const float* ss; int np;
    __device__ __forceinline__ void operator()(const Acc& acc, const Unit& u, int wr, int wc, int fr, int fq) const {
        const int row0 = u.pm * BM + wr * 64 + fr, col0 = u.pn * 128 + wc * 32 + 8 * fq;
        float rsv[2][4]; row_rstd8(ss, row0, fq, np, rsv);
#pragma unroll
        for (int ai = 0; ai < 2; ++ai)
#pragma unroll
            for (int m = 0; m < 4; ++m) { const int row = row0 + ai * HALF + m * 16; const float rs = rsv[ai][m];
                float h[8];
#pragma unroll
                for (int n = 0; n < 2; ++n)
#pragma unroll
                    for (int j = 0; j < 4; ++j) { const float gt = acc[ai][0][m][n][j] * rs, up = acc[ai][1][m][n][j] * rs; h[n * 4 + j] = gt * sigmoidf_(gt) * up; }
                u32x4 w; w.x = pk2(h[0], h[1]); w.y = pk2(h[2], h[3]); w.z = pk2(h[4], h[5]); w.w = pk2(h[6], h[7]);
                *(u32x4*)(H + (size_t)row * FF + col0) = w; }
    }
};
struct EpiResid { bf16_t* XBp; float* ss; float alpha;
    __device__ __forceinline__ void operator()(const Acc& acc, const Unit& u, int wr, int wc, int fr, int fq) const {
        const int row0 = u.pm * BM + wr * 64 + fr, col0 = u.pn * BM + wc * 32 + 8 * fq;
#pragma unroll
        for (int ai = 0; ai < 2; ++ai) {
            u32x4 xo[4][2];
#pragma unroll
            for (int m = 0; m < 4; ++m)
#pragma unroll
                for (int bj = 0; bj < 2; ++bj) xo[m][bj] = *(const u32x4*)(XBp + (size_t)(row0 + ai * HALF + m * 16) * DM + col0 + bj * HALF);
#pragma unroll
            for (int m = 0; m < 4; ++m) { const int row = row0 + ai * HALF + m * 16; float sq = 0.f;
#pragma unroll
                for (int bj = 0; bj < 2; ++bj) { bf16_t* p = XBp + (size_t)row * DM + col0 + bj * HALF; const u32x4 xv = xo[m][bj];
                    f32x4 x0 = (f32x4){bf_lo(xv.x), bf_hi(xv.x), bf_lo(xv.y), bf_hi(xv.y)}, x1 = (f32x4){bf_lo(xv.z), bf_hi(xv.z), bf_lo(xv.w), bf_hi(xv.w)};
                    x0 = x0 + alpha * acc[ai][bj][m][0]; x1 = x1 + alpha * acc[ai][bj][m][1];
                    u32x4 w; w.x = pk2(x0.x, x0.y); w.y = pk2(x0.z, x0.w); w.z = pk2(x1.x, x1.y); w.w = pk2(x1.z, x1.w);
                    *(u32x4*)p = w;
                    sq += (x0.x * x0.x + x0.y * x0.y) + (x0.z * x0.z + x0.w * x0.w) + (x1.x * x1.x + x1.y * x1.y) + (x1.z * x1.z + x1.w * x1.w); }
                sq = red_sum32(red_sum16(sq));
                if (fq == 0) ss[(size_t)row * 32 + u.pn * 4 + wc] = sq; }
        }
    }
};
struct EpiGluResid { bf16_t* XBp; float* ss; float mul;
    __device__ __forceinline__ void operator()(const Acc& acc, const Unit& u, int wr, int wc, int fr, int fq) const {
        const int row0 = u.pm * BM + wr * 64 + fr, col0 = u.pn * 128 + wc * 32 + 8 * fq;
        u32x4 xo[2][4];
#pragma unroll
        for (int ai = 0; ai < 2; ++ai)
#pragma unroll
            for (int m = 0; m < 4; ++m) xo[ai][m] = *(const u32x4*)(XBp + (size_t)(row0 + ai * HALF + m * 16) * DM + col0);
#pragma unroll
        for (int ai = 0; ai < 2; ++ai)
#pragma unroll
            for (int m = 0; m < 4; ++m) { const int row = row0 + ai * HALF + m * 16; bf16_t* p = XBp + (size_t)row * DM + col0; const u32x4 xv = xo[ai][m];
                f32x4 x0 = (f32x4){bf_lo(xv.x), bf_hi(xv.x), bf_lo(xv.y), bf_hi(xv.y)}, x1 = (f32x4){bf_lo(xv.z), bf_hi(xv.z), bf_lo(xv.w), bf_hi(xv.w)};
#pragma unroll
                for (int j = 0; j < 4; ++j) { x0[j] += mul * acc[ai][0][m][0][j] * sigmoidf_(acc[ai][1][m][0][j]); x1[j] += mul * acc[ai][0][m][1][j] * sigmoidf_(acc[ai][1][m][1][j]); }
                u32x4 w; w.x = pk2(x0.x, x0.y); w.y = pk2(x0.z, x0.w); w.z = pk2(x1.x, x1.y); w.w = pk2(x1.z, x1.w);
                *(u32x4*)p = w;
                float sq = (x0.x * x0.x + x0.y * x0.y) + (x0.z * x0.z + x0.w * x0.w) + (x1.x * x1.x + x1.y * x1.y) + (x1.z * x1.z + x1.w * x1.w);
                sq = red_sum32(red_sum16(sq));
                if (fq == 0) ss[(size_t)row * 32 + u.pn * 4 + wc] = sq; }
    }
};
template <bool SCALE> struct EpiBf { bf16_t* O; int ldc; const float* ss; int np; float mul;
    __device__ __forceinline__ void operator()(const Acc& acc, const Unit& u, int wr, int wc, int fr, int fq) const {
        const int row0 = u.pm * BM + wr * 64 + fr, col0 = u.pn * BM + wc * 32 + 8 * fq;
        float rsv[2][4]; if (SCALE) row_rstd8(ss, row0, fq, np, rsv);
#pragma unroll
        for (int ai = 0; ai < 2; ++ai)
#pragma unroll
            for (int m = 0; m < 4; ++m) { const int row = row0 + ai * HALF + m * 16; float rs = mul; if (SCALE) rs *= rsv[ai][m];
#pragma unroll
                for (int bj = 0; bj < 2; ++bj) { const f32x4 v0 = acc[ai][bj][m][0] * rs, v1 = acc[ai][bj][m][1] * rs;
                    u32x4 w; w.x = pk2(v0.x, v0.y); w.y = pk2(v0.z, v0.w); w.z = pk2(v1.x, v1.y); w.w = pk2(v1.z, v1.w);
                    *(u32x4*)(O + (size_t)row * ldc + col0 + bj * HALF) = w; } }
    }
};
struct EpiU { bf16_t* U; const float* ss; int np;
    __device__ __forceinline__ void operator()(const Acc& acc, const Unit& u, int wr, int wc, int fr, int fq) const {
        const int row0 = u.pm * BM + wr * 64 + fr, col0 = u.pn * BM + wc * 32 + 8 * fq;
        float rsv[2][4]; row_rstd8(ss, row0, fq, np, rsv);
#pragma unroll
        for (int ai = 0; ai < 2; ++ai)
#pragma unroll
            for (int m = 0; m < 4; ++m) { const int row = row0 + ai * HALF + m * 16; const float rs = rsv[ai][m]; const int chunk = row >> 6, j = row & 63;
#pragma unroll
                for (int bj = 0; bj < 2; ++bj) { const int col = col0 + bj * HALF, gg = col >> 4, cp = col & 15; const f32x4 v0 = acc[ai][bj][m][0] * rs, v1 = acc[ai][bj][m][1] * rs;
                    u32x4 w; w.x = pk2(v0.x, v0.y); w.y = pk2(v0.z, v0.w); w.z = pk2(v1.x, v1.y); w.w = pk2(v1.z, v1.w);
                    *(u32x4*)(U + ((size_t)gg * NCH + chunk) * UP_LD + 128 + j * 16 + cp) = w; } }
    }
};
struct EpiMemKV { float* out; const float* ss;
    __device__ __forceinline__ void operator()(const Acc& acc, const Unit& u, int wr, int wc, int fr, int fq) const {
        const int row0 = u.pm * BM + wr * 64 + fr, l = u.pn >> 3, kv = (u.pn >> 2) & 1, col0 = (u.pn & 3) * BM + wc * 32 + 8 * fq;
        float* base = out + (kv ? O_MVP : O_MKP) + (size_t)l * 4096 * 1024;
#pragma unroll
        for (int ai = 0; ai < 2; ++ai)
#pragma unroll
            for (int m = 0; m < 4; ++m) { const int row = row0 + ai * HALF + m * 16; const float rs = row_rstd(ss, row, fq, 16);
#pragma unroll
                for (int bj = 0; bj < 2; ++bj) { float* p = base + (size_t)row * 1024 + col0 + bj * HALF; *(f32x4*)p = acc[ai][bj][m][0] * rs; *(f32x4*)(p + 4) = acc[ai][bj][m][1] * rs; } }
    }
};
struct EpiE { float* Eo;
    __device__ __forceinline__ void operator()(const Acc& acc, const Unit& u, int wr, int wc, int fr, int fq) const {
        const int row0 = u.pm * BM + wr * 64 + fr, col0 = wc * 32 + 8 * fq;
#pragma unroll
        for (int ai = 0; ai < 2; ++ai)
#pragma unroll
            for (int m = 0; m < 4; ++m) { const int row = row0 + ai * HALF + m * 16;
                if (row < NCH) { float* p = Eo + ((size_t)u.pb * NCH + row) * 128 + col0; *(f32x4*)p = acc[ai][0][m][0]; *(f32x4*)(p + 4) = acc[ai][0][m][1]; } }
    }
};
struct EpiY { bf16_t* Y; const bf16_t* U; const float* dsk;
    __device__ __forceinline__ void operator()(const Acc& acc, const Unit& u, int wr, int wc, int fr, int fq) const {
        const int row0 = u.pm * BM + wr * 64 + fr, col0 = u.pn * BM + wc * 32 + 8 * fq, c = col0 & 15;
        const f32x4 d0 = *(const f32x4*)(dsk + u.pb * 16 + c), d1 = *(const f32x4*)(dsk + u.pb * 16 + c + 4);
        u32x4 uv[2][4][2];
#pragma unroll
        for (int ai = 0; ai < 2; ++ai)
#pragma unroll
            for (int m = 0; m < 4; ++m)
#pragma unroll
                for (int bj = 0; bj < 2; ++bj) { const int row = min(row0 + ai * HALF + m * 16, NCH - 1); uv[ai][m][bj] = *(const u32x4*)(U + ((size_t)u.pb * NCH + row) * UP_LD + 128 + col0 + bj * HALF); }
#pragma unroll
        for (int ai = 0; ai < 2; ++ai)
#pragma unroll
            for (int m = 0; m < 4; ++m) { const int row = row0 + ai * HALF + m * 16;
                if (row < NCH) {
#pragma unroll
                    for (int bj = 0; bj < 2; ++bj) { const int n = col0 + bj * HALF, l = n >> 4;
                        const u32x4 uu = uv[ai][m][bj];
                        float y[8];
                        y[0] = acc[ai][bj][m][0].x + d0.x * bf_lo(uu.x); y[1] = acc[ai][bj][m][0].y + d0.y * bf_hi(uu.x); y[2] = acc[ai][bj][m][0].z + d0.z * bf_lo(uu.y); y[3] = acc[ai][bj][m][0].w + d0.w * bf_hi(uu.y);
                        y[4] = acc[ai][bj][m][1].x + d1.x * bf_lo(uu.z); y[5] = acc[ai][bj][m][1].y + d1.y * bf_hi(uu.z); y[6] = acc[ai][bj][m][1].z + d1.z * bf_lo(uu.w); y[7] = acc[ai][bj][m][1].w + d1.w * bf_hi(uu.w);
#pragma unroll
                        for (int j = 0; j < 8; ++j) { const float v = y[j], z = 1.59576912f * (v + 0.044715f * v * v * v); y[j] = v * sigmoidf_(z); }
                        u32x4 w; w.x = pk2(y[0], y[1]); w.y = pk2(y[2], y[3]); w.z = pk2(y[4], y[5]); w.w = pk2(y[6], y[7]);
                        *(u32x4*)(Y + ((size_t)u.pb * T + (size_t)row * 64 + l) * 16 + c) = w; } } }
    }
};
}

template <int MODE>
__device__ __forceinline__ void attn_phase(LAS unsigned char* lds, const bf16_t* Q, const bf16_t* kvb, const bf16_t* krb, const bf16_t* kxb, const bf16_t* vxt, bf16_t* O) {
    constexpr int DQK = MODE ? 256 : 96, DV = MODE ? 256 : 64, KSTR = DQK + 8, VSTR = 72, NKS = DQK / 32, NDB = DV / 16, LDQ = MODE ? 1024 : 768;
    constexpr int HALF_BYTES = 64 * KSTR * 2 + DV * VSTR * 2, NITEM = MODE ? 1152 : 2304, NKR = MODE ? 4 : 2, NVR = MODE ? 4 : 1, NDW = NDB;
    const int tid = threadIdx.x, wid = __builtin_amdgcn_readfirstlane(tid >> 6), lane = tid & 63, w = wid, th = tid, fr = lane & 15, fq = lane >> 4;
    LAS bf16_t* Ks = (LAS bf16_t*)lds; LAS bf16_t* Vt = Ks + 64 * KSTR;
    for (int rnd = 0; rnd * (int)gridDim.x < NITEM; ++rnd) {
        const int it = rnd * (int)gridDim.x + ((MODE == 0 && (rnd & 1)) ? ((int)gridDim.x - 1 - (int)blockIdx.x) : (int)blockIdx.x);
        if (it >= NITEM) continue;
        int qrow0, ntiles, h, kvrow0 = 0, pos0 = 0, wq = w; bool wactive = true; const bf16_t* kbase = nullptr; const bf16_t* vbase = nullptr;
        int my_nt = 0;
        if (MODE == 0) {
            int L = it, b, j = -1;
            if (L < 1024) { j = 15 - (L >> 7); b = (L & 127) >> 3; h = L & 7; }
            else if (L < 1280) { L -= 1024; b = L >> 3; h = L & 7; }
            else { L -= 1280; j = 7 - (L >> 7); b = (L & 127) >> 3; h = L & 7; }
            if (j >= 0) { qrow0 = b * 2048 + 128 * j; kvrow0 = b * 2048; ntiles = 2 * j + 2; pos0 = 128 * j; my_nt = 2 * j + 1 + (w >> 2); }
            else { qrow0 = TP + b * 64; kvrow0 = TP + b * 1088; ntiles = 17; pos0 = 1024; wq = w & 3; wactive = w < 4; my_nt = wactive ? 17 : 0; }
        } else {
            int bg; h = it & 3; ntiles = 4;
            if (it < 1024) { bg = it >> 6; qrow0 = bg * 2048 + ((it >> 2) & 15) * 128; }
            else { const int b = (it - 1024) >> 2; bg = 16 + b; qrow0 = TP + b * 64; wq = w & 3; wactive = w < 4; }
            my_nt = 4;
            kbase = kxb + (size_t)bg * 262144 + h * 256; vbase = vxt + (size_t)(bg * 4 + h) * 65536;
        }
        bf16x8 qf[NKS];
        { const bf16_t* qp = Q + (size_t)(qrow0 + 16 * wq + fr) * LDQ + h * DQK + 8 * fq;
#pragma unroll
          for (int k = 0; k < NKS; ++k) qf[k] = *(const bf16x8*)(qp + 32 * k); }
        if (MODE == 0) {
            const float pos = (float)(pos0 + 16 * wq + fr); float y[8];
#pragma unroll
            for (int j = 0; j < 8; ++j) { const float x = bf2f((unsigned short)qf[2][j]), xp = lane_xor32(x, fq); float cs, sn; cis_turns(pos * rope_ift(8 * (fq & 1) + j), cs, sn);
                y[j] = (fq < 2) ? x * cs - xp * sn : xp * sn + x * cs; }
#pragma unroll
            for (int j = 0; j < 8; j += 2) { const unsigned pw = pk2(y[j], y[j + 1]); qf[2][j] = (short)(pw & 0xffffu); qf[2][j + 1] = (short)(pw >> 16); }
        }
        f32x4 ot[NDW];
#pragma unroll
        for (int d = 0; d < NDW; ++d) ot[d] = (f32x4){0.f, 0.f, 0.f, 0.f};
        float mrun = -1e30f, lrun = 0.f;
        u32x4 kr[NKR], vr[NVR];
#define ATT_LD(kt_) do { \
        if (MODE == 0) { \
            _Pragma("unroll") for (int r = 0; r < 2; ++r) { const int q = th + 512 * r; if (q < 768) { const int key = q / 12, pc = q % 12; const size_t krow = (size_t)(kvrow0 + 64 * (kt_) + key); \
                kr[r] = *(const u32x4*)(pc < 8 ? kvb + krow * 1024 + h * 128 + 8 * pc : krb + krow * 32 + 8 * (pc - 8)); } } \
            { const int key = th & 63, pc = th >> 6; const size_t krow = (size_t)(kvrow0 + 64 * (kt_) + key); \
                vr[0] = *(const u32x4*)(kvb + krow * 1024 + h * 128 + 64 + 8 * pc); } \
        } else { \
            _Pragma("unroll") for (int r = 0; r < 4; ++r) { const int q = th + 512 * r; kr[r] = *(const u32x4*)(kbase + (size_t)(64 * (kt_) + (q >> 5)) * 1024 + 8 * (q & 31)); \
                vr[r] = *(const u32x4*)(vbase + (size_t)(q >> 3) * 256 + 64 * (kt_) + 8 * (q & 7)); } \
        } } while (0)
        ATT_LD(0);
        for (int kt = 0; kt < ntiles; ++kt) {
            __syncthreads();
            if (MODE == 0) {
#pragma unroll
                for (int r = 0; r < 2; ++r) { const int q = th + 512 * r; if (q < 768) { const int key = q / 12, pc = q % 12; *(LAS u32x4*)(Ks + key * KSTR + 8 * pc) = kr[r]; } }
                { const int key = th & 63, pc = th >> 6; const u32x4 v = vr[0]; LAS bf16_t* d = Vt + (8 * pc) * VSTR + key;
                    d[0] = (bf16_t)(v.x & 0xffffu); d[VSTR] = (bf16_t)(v.x >> 16); d[2 * VSTR] = (bf16_t)(v.y & 0xffffu); d[3 * VSTR] = (bf16_t)(v.y >> 16);
                    d[4 * VSTR] = (bf16_t)(v.z & 0xffffu); d[5 * VSTR] = (bf16_t)(v.z >> 16); d[6 * VSTR] = (bf16_t)(v.w & 0xffffu); d[7 * VSTR] = (bf16_t)(v.w >> 16); }
            } else {
#pragma unroll
                for (int r = 0; r < 4; ++r) { const int q = th + 512 * r; *(LAS u32x4*)(Ks + (q >> 5) * KSTR + 8 * (q & 31)) = kr[r]; *(LAS u32x4*)(Vt + (q >> 3) * VSTR + 8 * (q & 7)) = vr[r]; }
            }
            __syncthreads();
            if (kt + 1 < ntiles) ATT_LD(kt + 1);
            if (kt < my_nt) {
            f32x4 st[4];
#pragma unroll
            for (int nb = 0; nb < 4; ++nb) { st[nb] = (f32x4){0.f, 0.f, 0.f, 0.f};
#pragma unroll
                for (int k = 0; k < NKS; ++k) { const bf16x8 a = *(const LAS bf16x8*)(Ks + (16 * nb + fr) * KSTR + 32 * k + 8 * fq); st[nb] = __builtin_amdgcn_mfma_f32_16x16x32_bf16(a, qf[k], st[nb], 0, 0, 0); } }
            float mx = -1e30f;
#pragma unroll
            for (int nb = 0; nb < 4; ++nb) mx = fmaxf(mx, fmaxf(fmaxf(st[nb].x, st[nb].y), fmaxf(st[nb].z, st[nb].w)));
            mx = red_max32(red_max16(mx));
            const float mnew = fmaxf(mrun, mx), alpha = __builtin_amdgcn_exp2f(mrun - mnew); mrun = mnew;
            float lsum = 0.f;
#pragma unroll
            for (int nb = 0; nb < 4; ++nb)
#pragma unroll
                for (int j = 0; j < 4; ++j) { const float p = __builtin_amdgcn_exp2f(st[nb][j] - mnew); st[nb][j] = p; lsum += p; }
            lrun = lrun * alpha + lsum;
#pragma unroll
            for (int d = 0; d < NDW; ++d) ot[d] = ot[d] * alpha;
#pragma unroll
            for (int k2 = 0; k2 < 2; ++k2) {
                bf16x8 pb; { const unsigned w0 = pk2(st[2 * k2].x, st[2 * k2].y), w1 = pk2(st[2 * k2].z, st[2 * k2].w), w2 = pk2(st[2 * k2 + 1].x, st[2 * k2 + 1].y), w3 = pk2(st[2 * k2 + 1].z, st[2 * k2 + 1].w);
                    pb[0] = (short)(w0 & 0xffffu); pb[1] = (short)(w0 >> 16); pb[2] = (short)(w1 & 0xffffu); pb[3] = (short)(w1 >> 16); pb[4] = (short)(w2 & 0xffffu); pb[5] = (short)(w2 >> 16); pb[6] = (short)(w3 & 0xffffu); pb[7] = (short)(w3 >> 16); }
#pragma unroll
                for (int d = 0; d < NDW; ++d) { const LAS bf16_t* vp_ = Vt + (16 * d + fr) * VSTR + 32 * k2 + 4 * fq;
                    const bf16x4 lo = *(const LAS bf16x4*)vp_, hi = *(const LAS bf16x4*)(vp_ + 16);
                    bf16x8 a; a[0] = lo[0]; a[1] = lo[1]; a[2] = lo[2]; a[3] = lo[3]; a[4] = hi[0]; a[5] = hi[1]; a[6] = hi[2]; a[7] = hi[3];
                    ot[d] = __builtin_amdgcn_mfma_f32_16x16x32_bf16(a, pb, ot[d], 0, 0, 0); }
            }
            }
        }
#undef ATT_LD
        const float lt = red_sum32(red_sum16(lrun)); const float inv = fast_rcp(lt);
        bf16_t* op = O + (size_t)(qrow0 + 16 * wq + fr) * 1024 + h * DV + 4 * fq;
        if (wactive) {
#pragma unroll
            for (int d = 0; d < NDW; ++d) { u32x2 o; o.x = pk2(ot[d].x * inv, ot[d].y * inv); o.y = pk2(ot[d].z * inv, ot[d].w * inv); *(u32x2*)(op + 16 * d) = o; }
        }
    }
}

__device__ __forceinline__ void tr_loop(const float* W, int K, int N, const float* gain, bf16_t* WT, int row_off, int mode, LAS float* scr, int gw, int ngw, int lane) {
    const int nblk = N / 32, nitems = (K / 64) * nblk, half = N >> 1;
    for (int item = gw; item < nitems; item += ngw) {
        const int kb = item / nblk, nb = item % nblk, k0 = 64 * kb, n0 = 32 * nb;
#pragma unroll 8
        for (int i = 0; i < 32; ++i) { const int kk = 2 * i + (lane >> 5); float v = W[(size_t)(k0 + kk) * N + n0 + (lane & 31)]; if (gain) v *= gain[k0 + kk]; scr[kk * 33 + (lane & 31)] = v; }
        asm volatile("s_waitcnt lgkmcnt(0)" ::: "memory");
        const int c = lane & 7;
#pragma unroll
        for (int j = 0; j < 4; ++j) { const int n = (lane >> 3) + 8 * j; const LAS float* s = scr + (8 * c) * 33 + n;
            u32x4 o; o.x = pk2(s[0], s[33]); o.y = pk2(s[66], s[99]); o.z = pk2(s[132], s[165]); o.w = pk2(s[198], s[231]);
            const int col = n0 + n; int row;
            if (mode == 0) row = row_off + col; else { const int hs = col >= half ? 1 : 0, cc = col - hs * half; row = (cc >> 7) * 256 + hs * 128 + (cc & 127); }
            *(u32x4*)(WT + (size_t)row * K + k0 + 8 * c) = o; }
        asm volatile("s_waitcnt lgkmcnt(0)" ::: "memory");
    }
}

constexpr int LDS_BYTES = 2 * (64 * 264 * 2 + 256 * 72 * 2);
struct Args { const float* in[41]; float* out; unsigned char* ws; int ph_lo, ph_hi; };

__device__ __forceinline__ void tr_weight_job(const Args& a, unsigned char* ws, int j, LAS float* scr, int gw, int ngw, int lane) {
                const float* W; const float* gain = nullptr; bf16_t* WT; int K, N, mode = 0, roff = 0;
                switch (j) {
                    case 0: W = a.in[11]; gain = a.in[10]; WT = (bf16_t*)(ws + W_GU_A); K = 1024; N = 5632; mode = 1; break;
                    case 1: W = a.in[12]; WT = (bf16_t*)(ws + W_DN_A); K = 2816; N = 1024; break;
                    case 2: W = a.in[38]; gain = a.in[37]; WT = (bf16_t*)(ws + W_GU_B); K = 1024; N = 5632; mode = 1; break;
                    case 3: W = a.in[39]; WT = (bf16_t*)(ws + W_DN_B); K = 2816; N = 1024; break;
                    case 4: W = a.in[14]; gain = a.in[13]; WT = (bf16_t*)(ws + W_INE); K = 1024; N = 2080; break;
                    case 5: W = a.in[17]; WT = (bf16_t*)(ws + W_UQ); K = 256; N = 768; break;
                    case 6: W = a.in[18]; WT = (bf16_t*)(ws + W_UKV); K = 256; N = 1024; break;
                    case 7: W = a.in[20]; WT = (bf16_t*)(ws + W_OUT); K = 1024; N = 1024; break;
                    case 8: W = a.in[21]; gain = a.in[13] + 1024; WT = (bf16_t*)(ws + W_INO); K = 1024; N = 1024; break;
                    case 9: W = a.in[30]; WT = (bf16_t*)(ws + W_GLU); K = 1024; N = 2048; mode = 1; break;
                    case 10: W = a.in[33]; gain = a.in[31]; WT = (bf16_t*)(ws + W_XQ); K = 1024; N = 1024; break;
                    case 11: W = a.in[33] + 1048576; gain = a.in[31] + 1024; WT = (bf16_t*)(ws + W_XQ) + 1048576; K = 1024; N = 1024; break;
                    case 12: W = a.in[36]; WT = (bf16_t*)(ws + W_XO); K = 1024; N = 1024; break;
                    case 13: W = a.in[36] + 1048576; WT = (bf16_t*)(ws + W_XO) + 1048576; K = 1024; N = 1024; break;
                    case 14: W = a.in[34]; gain = a.in[32]; WT = (bf16_t*)(ws + W_MEM); K = 1024; N = 1024; roff = 0; break;
                    case 15: W = a.in[35]; gain = a.in[32]; WT = (bf16_t*)(ws + W_MEM); K = 1024; N = 1024; roff = 1024; break;
                    case 16: W = a.in[34] + 1048576; gain = a.in[32] + 1024; WT = (bf16_t*)(ws + W_MEM); K = 1024; N = 1024; roff = 2048; break;
                    default: W = a.in[35] + 1048576; gain = a.in[32] + 1024; WT = (bf16_t*)(ws + W_MEM); K = 1024; N = 1024; roff = 3072; break;
                }
                tr_loop(W, K, N, gain, WT, roff, mode, scr, gw, ngw, lane);
}

template <int ph, bool SECOND = false>
__device__ __forceinline__ void run_phase(const Args& a, LAS unsigned char* lds, const XcdBarrier& xbar) {
    constexpr float RMUL = SECOND ? 0.0f : 1.0f;
    const int tid = threadIdx.x, lane = tid & 63, wid = __builtin_amdgcn_readfirstlane(tid >> 6);
    const int gw = blockIdx.x * 8 + wid, ngw = gridDim.x * 8, gt = blockIdx.x * 512 + tid, ngt = gridDim.x * 512;
    unsigned char* ws = a.ws; float* out = a.out;
    bf16_t* xb = (bf16_t*)(ws + XB); float* ss = (float*)(ws + SS);
    LAS float* scr = (LAS float*)(lds + wid * 8448);
    const bool fastffn = (gridDim.x == 256);
    const int nbusy = 544 % (int)gridDim.x, tailb = (int)blockIdx.x - nbusy, gwt = tailb * 8 + wid, ngwt = ((int)gridDim.x - nbusy) * 8, gtt = tailb * 512 + tid, ngtt = ((int)gridDim.x - nbusy) * 512;

    {
        constexpr int layer = (ph >= 13 && ph != 26) ? 1 : 0;
        switch (ph) {
        case 0: if (PH_ON(0)) {
            for (int j = 0; j < 18; ++j) if (j < 2 || j >= 14) tr_weight_job(a, ws, j, scr, gw, ngw, lane);
            for (int row0 = gw; row0 < T; row0 += 4 * ngw) {
                f32x4 v[4][4]; bool ok[4];
#pragma unroll
                for (int q = 0; q < 4; ++q) { const int row = row0 + q * ngw; ok[q] = row < T; const int rr = ok[q] ? row : gw;
                    const float* src = rr < TP ? a.in[0] + (size_t)rr * DM : a.in[1] + (size_t)(rr - TP) * DM;
#pragma unroll
                    for (int j = 0; j < 4; ++j) v[q][j] = *(const f32x4*)(src + 4 * lane + 256 * j); }
#pragma unroll
                for (int q = 0; q < 4; ++q) { const int row = row0 + q * ngw; float s = 0.f;
#pragma unroll
                    for (int j = 0; j < 4; ++j) { const f32x4 w = v[q][j]; s += (w.x * w.x + w.y * w.y) + (w.z * w.z + w.w * w.w);
                        if (ok[q]) { u32x2 o; o.x = pk2(w.x, w.y); o.y = pk2(w.z, w.w); *(u32x2*)(xb + (size_t)row * DM + 4 * lane + 256 * j) = o; } }
                    s = wave_sum(s); if (ok[q] && lane < 16) ss[(size_t)row * 32 + lane] = lane == 0 ? s : 0.f; }
            }
            { bf16_t* memb = (bf16_t*)(ws + MEMB); float* ssm = (float*)(ws + SSMEM);
              for (int row = gw; row < 4096; row += ngw) { const float* src = a.in[9] + (size_t)row * DM; float s = 0.f;
#pragma unroll
                for (int j = 0; j < 4; ++j) { const f32x4 v = *(const f32x4*)(src + 4 * lane + 256 * j);
                    u32x2 o; o.x = pk2(v.x, v.y); o.y = pk2(v.z, v.w); *(u32x2*)(memb + (size_t)row * DM + 4 * lane + 256 * j) = o; s += (v.x * v.x + v.y * v.y) + (v.z * v.z + v.w * v.w); }
                s = wave_sum(s); if (lane < 16) ssm[(size_t)row * 32 + lane] = lane == 0 ? s : 0.f; } }
            { bf16_t* latall = (bf16_t*)(ws + LATALL); bf16_t* krb = (bf16_t*)(ws + KRB);
              for (int r0 = gw; r0 < 32 * 1024; r0 += 4 * ngw) {
                f32x4 v[4];
#pragma unroll
                for (int q = 0; q < 4; ++q) { const int r = min(r0 + q * ngw, 32 * 1024 - 1); v[q] = *(const f32x4*)(a.in[2] + (size_t)r * 256 + 4 * lane); }
#pragma unroll
                for (int q = 0; q < 4; ++q) { const int r = r0 + q * ngw; if (r < 32 * 1024) { const int b = r >> 10, s = r & 1023;
                    u32x2 o; o.x = pk2(v[q].x, v[q].y); o.y = pk2(v[q].z, v[q].w); *(u32x2*)(latall + (size_t)(TP + b * 1088 + s) * 256 + 4 * lane) = o; } } }
              for (int i = gt; i < 32 * 1024 * 8; i += ngt) { const int r = i >> 3, pc = i & 7, b = r >> 10, s = r & 1023; const f32x4 v = *(const f32x4*)(a.in[3] + (size_t)r * 32 + 4 * pc);
                u32x2 o; o.x = pk2(v.x, v.y); o.y = pk2(v.z, v.w); *(u32x2*)(krb + (size_t)(TP + b * 1088 + s) * 32 + 4 * pc) = o; } }
        } break;
        case 1: case 11: case 13: case 23: if (PH_ON(1)) {
            const bool second = (ph == 11 || ph == 23);
            if (ph == 1) {
                pg8::Gemm g{(const bf16_t*)(ws + MEMB), (const bf16_t*)(ws + W_MEM), 1024, 1024, 1024, 16, 16, 1, 0, 0};
                pg8::EpiMemKV E{out, (const float*)(ws + SSMEM)}; pg8::gemm_phase(lds, g, E);
            }
            if (fastffn) {
                pg8::EpiSwiglu E{(bf16_t*)(ws + HBUF), ss, 16};
                { pg8::Gemm g{xb, (const bf16_t*)(ws + (second ? W_GU_B : W_GU_A)), 1024, 1024, 1024, 136, 22, 1, 0, 0, 0, 0, 1}; pg8::gemm_phase(lds, g, E); }
                xcd_barrier(xbar);
                { pg8::Gemm g{xb, (const bf16_t*)(ws + (second ? W_GU_B : W_GU_A)), 1024, 1024, 1024, 136, 22, 1, 0, 0, 0, 0, 2}; pg8::gemm_phase(lds, g, E); }
                { pg8::Gemm g{(const bf16_t*)(ws + HBUF), (const bf16_t*)(ws + (second ? W_DN_B : W_DN_A)), FF, FF, FF, 136, 4, 1, 0, 0, 0, 0, 3};
                  pg8::EpiResid Ed{xb, ss, 0.5f * RMUL}; pg8::gemm_phase(lds, g, Ed); }
            } else {
                pg8::Gemm g{xb, (const bf16_t*)(ws + (second ? W_GU_B : W_GU_A)), 1024, 1024, 1024, 136, 22, 1, 0, 0};
                pg8::EpiSwiglu E{(bf16_t*)(ws + HBUF), ss, 16}; pg8::gemm_phase(lds, g, E);
            }
        } break;
        case 2: case 12: case 14: case 24: if (PH_ON(2)) {
            const bool second = (ph == 12 || ph == 24);
            pg8::Gemm g{(const bf16_t*)(ws + HBUF), (const bf16_t*)(ws + (second ? W_DN_B : W_DN_A)), FF, FF, FF, fastffn ? 128 : 136, 4, 1, 0, 0};
            pg8::EpiResid E{xb, ss, 0.5f * RMUL}; pg8::gemm_phase(lds, g, E);
            const bool dojobs = fastffn || tailb >= 0; const int jw = fastffn ? gw : gwt, jnw = fastffn ? ngw : ngwt, jt = fastffn ? gt : gtt, jnt = fastffn ? ngt : ngtt;
            if (ph == 2 && !SECOND && dojobs) {
                __syncthreads();
                tr_weight_job(a, ws, 4, scr, jw, jnw, lane); tr_weight_job(a, ws, 5, scr, jw, jnw, lane); tr_weight_job(a, ws, 6, scr, jw, jnw, lane); tr_weight_job(a, ws, 7, scr, jw, jnw, lane);
            }
        } break;
        case 3: if (PH_ON(3)) {
            pg8::Gemm g{xb, (const bf16_t*)(ws + W_INE), 1024, 1024, 1024, 136, 9, 1, 0, 0};
            pg8::EpiBf<true> E{(bf16_t*)(ws + EVB), EV_LD, ss, 16, 1.0f}; pg8::gemm_phase(lds, g, E);
        } break;
        case 4: if (PH_ON(4)) {
            const bf16_t* evb = (const bf16_t*)(ws + EVB); bf16_t* cqn = (bf16_t*)(ws + CQN); bf16_t* latall = (bf16_t*)(ws + LATALL); bf16_t* krb = (bf16_t*)(ws + KRB); bf16_t* mixcat = (bf16_t*)(ws + MIXCAT);
            const float* qn = a.in[15]; const float* kvn = a.in[16]; const float* cw = a.in[19];
            for (int t = gw; t < T; t += ngw) {
                const bf16_t* ev = evb + (size_t)t * EV_LD; int s, S, kvrow; float pos; float* lat_o; float* kr_o; float* cv_o; const float* past = nullptr;
                if (t < TP) { const int b = t >> 11; s = t & 2047; S = 2048; pos = (float)s; kvrow = t; lat_o = out + O_LATP + (size_t)t * 256; kr_o = out + O_KRP + (size_t)t * 32; cv_o = out + O_CONVP + b * 1024; }
                else { const int ts = t - TP, b = ts >> 6; s = ts & 63; S = 64; pos = (float)(1024 + s); kvrow = TP + b * 1088 + 1024 + s; lat_o = out + O_LATS + (size_t)ts * 256; kr_o = out + O_KRS + (size_t)ts * 32; cv_o = out + O_CONVS + b * 1024; past = a.in[4] + b * 1024; }
                const bf16_t* e1 = ev - (s >= 1 ? EV_LD : 0); const bf16_t* e2 = ev - (s >= 2 ? 2 * EV_LD : 0);
                const u32x2 w_cq = *(const u32x2*)(ev + 4 * lane), w_ckv = *(const u32x2*)(ev + 256 + 4 * lane);
                const unsigned short kr1 = ev[512 + (lane & 15)], kr2 = ev[528 + (lane & 15)];
                const u32x4 gc0 = *(const u32x4*)(ev + 1056 + 8 * lane), vi0 = *(const u32x4*)(ev + 1568 + 8 * lane), gb0 = *(const u32x4*)(ev + 544 + 8 * lane);
                const u32x4 gc1 = *(const u32x4*)(e1 + 1056 + 8 * lane), vi1 = *(const u32x4*)(e1 + 1568 + 8 * lane), gc2 = *(const u32x4*)(e2 + 1056 + 8 * lane), vi2 = *(const u32x4*)(e2 + 1568 + 8 * lane);
                const f32x4 gq = *(const f32x4*)(qn + 4 * lane), gk = *(const f32x4*)(kvn + 4 * lane);
                const f32x4 cw0a = *(const f32x4*)(cw + 8 * lane), cw0b = *(const f32x4*)(cw + 8 * lane + 4), cw1a = *(const f32x4*)(cw + 512 + 8 * lane), cw1b = *(const f32x4*)(cw + 512 + 8 * lane + 4), cw2a = *(const f32x4*)(cw + 1024 + 8 * lane), cw2b = *(const f32x4*)(cw + 1024 + 8 * lane + 4);
                { const u32x2 w = w_cq; const float c0 = bf_lo(w.x), c1 = bf_hi(w.x), c2 = bf_lo(w.y), c3 = bf_hi(w.y);
                  const float rs = __builtin_amdgcn_rsqf(wave_sum((c0 * c0 + c1 * c1) + (c2 * c2 + c3 * c3)) * (1.0f / 256.0f) + EPS);
                  u32x2 o; o.x = pk2(c0 * rs * gq.x, c1 * rs * gq.y); o.y = pk2(c2 * rs * gq.z, c3 * rs * gq.w); *(u32x2*)(cqn + (size_t)t * 256 + 4 * lane) = o; }
                { const u32x2 w = w_ckv; const float c0 = bf_lo(w.x), c1 = bf_hi(w.x), c2 = bf_lo(w.y), c3 = bf_hi(w.y);
                  const float rs = __builtin_amdgcn_rsqf(wave_sum((c0 * c0 + c1 * c1) + (c2 * c2 + c3 * c3)) * (1.0f / 256.0f) + EPS);
                  f32x4 lv; lv.x = c0 * rs * gk.x; lv.y = c1 * rs * gk.y; lv.z = c2 * rs * gk.z; lv.w = c3 * rs * gk.w; *(f32x4*)(lat_o + 4 * lane) = lv;
                  u32x2 o; o.x = pk2(lv.x, lv.y); o.y = pk2(lv.z, lv.w); *(u32x2*)(latall + (size_t)kvrow * 256 + 4 * lane) = o; }
                if (lane < 16) { const float x1 = bf2f(kr1), x2 = bf2f(kr2); float cs, sn; cis_turns(pos * rope_ift(lane), cs, sn);
                  const float o1 = x1 * cs - x2 * sn, o2 = x1 * sn + x2 * cs; kr_o[lane] = o1; kr_o[16 + lane] = o2; krb[(size_t)kvrow * 32 + lane] = f2bf(o1); krb[(size_t)kvrow * 32 + 16 + lane] = f2bf(o2); }
                {
                    float u0[8], u1[8], u2[8], gb[8];
                    { const u32x4 gc = gc0, vi = vi0, g_ = gb0;
                      u0[0] = bf_lo(gc.x) * bf_lo(vi.x); u0[1] = bf_hi(gc.x) * bf_hi(vi.x); u0[2] = bf_lo(gc.y) * bf_lo(vi.y); u0[3] = bf_hi(gc.y) * bf_hi(vi.y);
                      u0[4] = bf_lo(gc.z) * bf_lo(vi.z); u0[5] = bf_hi(gc.z) * bf_hi(vi.z); u0[6] = bf_lo(gc.w) * bf_lo(vi.w); u0[7] = bf_hi(gc.w) * bf_hi(vi.w);
                      gb[0] = bf_lo(g_.x); gb[1] = bf_hi(g_.x); gb[2] = bf_lo(g_.y); gb[3] = bf_hi(g_.y); gb[4] = bf_lo(g_.z); gb[5] = bf_hi(g_.z); gb[6] = bf_lo(g_.w); gb[7] = bf_hi(g_.w); }
                    if (s >= 1) { const u32x4 gc = gc1, vi = vi1;
                      u1[0] = bf_lo(gc.x) * bf_lo(vi.x); u1[1] = bf_hi(gc.x) * bf_hi(vi.x); u1[2] = bf_lo(gc.y) * bf_lo(vi.y); u1[3] = bf_hi(gc.y) * bf_hi(vi.y);
                      u1[4] = bf_lo(gc.z) * bf_lo(vi.z); u1[5] = bf_hi(gc.z) * bf_hi(vi.z); u1[6] = bf_lo(gc.w) * bf_lo(vi.w); u1[7] = bf_hi(gc.w) * bf_hi(vi.w); }
                    else if (past) { const f32x4 p0 = *(const f32x4*)(past + 512 + 8 * lane), p1 = *(const f32x4*)(past + 512 + 8 * lane + 4); u1[0] = p0.x; u1[1] = p0.y; u1[2] = p0.z; u1[3] = p0.w; u1[4] = p1.x; u1[5] = p1.y; u1[6] = p1.z; u1[7] = p1.w; }
                    else {
#pragma unroll
                        for (int j = 0; j < 8; ++j) u1[j] = 0.f; }
                    if (s >= 2) { const u32x4 gc = gc2, vi = vi2;
                      u2[0] = bf_lo(gc.x) * bf_lo(vi.x); u2[1] = bf_hi(gc.x) * bf_hi(vi.x); u2[2] = bf_lo(gc.y) * bf_lo(vi.y); u2[3] = bf_hi(gc.y) * bf_hi(vi.y);
                      u2[4] = bf_lo(gc.z) * bf_lo(vi.z); u2[5] = bf_hi(gc.z) * bf_hi(vi.z); u2[6] = bf_lo(gc.w) * bf_lo(vi.w); u2[7] = bf_hi(gc.w) * bf_hi(vi.w); }
                    else if (past) { const float* pp = past + s * 512 + 8 * lane; const f32x4 p0 = *(const f32x4*)pp, p1 = *(const f32x4*)(pp + 4); u2[0] = p0.x; u2[1] = p0.y; u2[2] = p0.z; u2[3] = p0.w; u2[4] = p1.x; u2[5] = p1.y; u2[6] = p1.z; u2[7] = p1.w; }
                    else {
#pragma unroll
                        for (int j = 0; j < 8; ++j) u2[j] = 0.f; }
                    float z[8];
#pragma unroll
                    for (int j = 0; j < 8; ++j) { const float k0 = j < 4 ? cw0a[j & 3] : cw0b[j & 3], k1 = j < 4 ? cw1a[j & 3] : cw1b[j & 3], k2 = j < 4 ? cw2a[j & 3] : cw2b[j & 3]; z[j] = gb[j] * (k0 * u2[j] + k1 * u1[j] + k2 * u0[j]); }
                    u32x4 o; o.x = pk2(z[0], z[1]); o.y = pk2(z[2], z[3]); o.z = pk2(z[4], z[5]); o.w = pk2(z[6], z[7]); *(u32x4*)(mixcat + (size_t)t * DM + 512 + 8 * lane) = o;
                    if (s >= S - 2) { float* cp_ = cv_o + (s - (S - 2)) * 512 + 8 * lane; *(f32x4*)cp_ = (f32x4){u0[0], u0[1], u0[2], u0[3]}; *(f32x4*)(cp_ + 4) = (f32x4){u0[4], u0[5], u0[6], u0[7]}; }
                }
            }
        } break;
        case 5: if (PH_ON(5)) {
            { pg8::Gemm g{(const bf16_t*)(ws + CQN), (const bf16_t*)(ws + W_UQ), 256, 256, 256, 136, 3, 1, 0, 0};
              pg8::EpiBf<false> E{(bf16_t*)(ws + QB), 768, nullptr, 16, 1.44269504f * 0.10206207f}; pg8::gemm_phase(lds, g, E); }
            { pg8::Gemm g{(const bf16_t*)(ws + LATALL), (const bf16_t*)(ws + W_UKV), 256, 256, 256, 264, 4, 1, 0, 0, 0, 0, 0, 104};
              pg8::EpiBf<false> E{(bf16_t*)(ws + KVB), 1024, nullptr, 16, 1.0f}; pg8::gemm_phase(lds, g, E); }
        } break;
        case 6: if (PH_ON(6)) {
            attn_phase<0>(lds, (const bf16_t*)(ws + QB), (const bf16_t*)(ws + KVB), (const bf16_t*)(ws + KRB), nullptr, nullptr, (bf16_t*)(ws + MIXCAT));
        } break;
        case 7: if (PH_ON(7)) {
            pg8::Gemm g{(const bf16_t*)(ws + MIXCAT), (const bf16_t*)(ws + W_OUT), 1024, 1024, 1024, 136, 4, 1, 0, 0};
            pg8::EpiResid E{xb, ss, 1.0f * RMUL}; pg8::gemm_phase(lds, g, E);
            if (!SECOND && tailb >= 0) {
                __syncthreads();
                if (!fastffn) {
                tr_loop(a.in[11] + (size_t)1024 * 5632, 1024, 5632, a.in[10] + 1024, (bf16_t*)(ws + W_GU_A), 0, 1, scr, gwt, ngwt, lane);
                tr_loop(a.in[12] + (size_t)2816 * 1024, 2816, 1024, nullptr, (bf16_t*)(ws + W_DN_A), 0, 0, scr, gwt, ngwt, lane);
                } else {
                for (int j = 2; j < 14; ++j) if (j < 4 || j >= 8) tr_weight_job(a, ws, j, scr, gwt, ngwt, lane);
            {
                float* klag = (float*)(ws + KLAG);
                for (int idx = gtt; idx < 65536; idx += ngtt) { const int g = idx >> 10, d = (idx >> 4) & 63, cp = idx & 15; const float dt = __expf(a.in[28][g]);
                    float accv[16];
#pragma unroll
                    for (int c = 0; c < 16; ++c) accv[c] = 0.f;
                    for (int p = 0; p < 64; ++p) { const float are = a.in[22][g * 64 + p], aim = a.in[23][g * 64 + p]; float abr, abi; cpow(are, aim, dt, 1.f, abr, abi);
                        const float nr = abr - 1.f, ni = abi, den = 1.0f / (are * are + aim * aim), fr_ = (nr * are + ni * aim) * den, fi = (ni * are - nr * aim) * den;
                        const float bre = a.in[24][(g * 64 + p) * 16 + cp], bim = a.in[25][(g * 64 + p) * 16 + cp], bbr = fr_ * bre - fi * bim, bbi = fr_ * bim + fi * bre;
                        float pr, pi; cpow(are, aim, dt, (float)d, pr, pi); const float wr_ = pr * bbr - pi * bbi, wi = pr * bbi + pi * bbr;
#pragma unroll
                        for (int c = 0; c < 16; ++c) accv[c] += a.in[26][(g * 16 + c) * 64 + p] * wr_ - a.in[27][(g * 16 + c) * 64 + p] * wi; }
#pragma unroll
                    for (int c = 0; c < 16; ++c) klag[((size_t)(g * 64 + d) * 16 + c) * 16 + cp] = accv[c]; }
            }
                }
            }
        } break;
        case 8: case 20: if (PH_ON(8)) {
            pg8::Gemm g{xb, (const bf16_t*)(ws + W_XQ) + (size_t)layer * 1048576, 1024, 1024, 1024, 136, 4, 1, 0, 0};
            pg8::EpiBf<true> E{(bf16_t*)(ws + QX), 1024, ss, ph == 20 ? 32 : 16, 0.0625f * 1.44269504f}; pg8::gemm_phase(lds, g, E);
            if (!SECOND && tailb >= 0) {
                __syncthreads();
                bf16_t* kx = (bf16_t*)(ws + KXB); bf16_t* vx = (bf16_t*)(ws + VXT);
                for (int bg = 0; bg < 48; ++bg) { const float* vsrc = bg < 16 ? out + O_MVP + (size_t)layer * 4194304 + (size_t)bg * 262144 : a.in[8] + (size_t)layer * 8388608 + (size_t)(bg - 16) * 262144;
                    tr_loop(vsrc, 256, 1024, nullptr, vx + (size_t)bg * 262144, 0, 0, scr, gwt, ngwt, lane); }
                for (int i = gtt; i < 48 * 32768; i += ngtt) { const int bg = i >> 15, e = (i & 32767) * 8;
                    const float* ksrc = (bg < 16 ? out + O_MKP + (size_t)layer * 4194304 + (size_t)bg * 262144 : a.in[7] + (size_t)layer * 8388608 + (size_t)(bg - 16) * 262144) + e;
                    const f32x4 v0 = *(const f32x4*)ksrc, v1 = *(const f32x4*)(ksrc + 4); u32x4 o; o.x = pk2(v0.x, v0.y); o.y = pk2(v0.z, v0.w); o.z = pk2(v1.x, v1.y); o.w = pk2(v1.z, v1.w);
                    *(u32x4*)(kx + (size_t)bg * 262144 + e) = o; }
            }
        } break;
        case 9: case 21: if (PH_ON(9)) {
            attn_phase<1>(lds, (const bf16_t*)(ws + QX), nullptr, nullptr, (const bf16_t*)(ws + KXB), (const bf16_t*)(ws + VXT), (bf16_t*)(ws + ATTX));
        } break;
        case 10: case 22: if (PH_ON(10)) {
            pg8::Gemm g{(const bf16_t*)(ws + ATTX), (const bf16_t*)(ws + W_XO) + (size_t)layer * 1048576, 1024, 1024, 1024, 136, 4, 1, 0, 0};
            pg8::EpiResid E{xb, ss, 1.0f * RMUL}; pg8::gemm_phase(lds, g, E);
            if (fastffn && !SECOND && tailb >= 0) {
                __syncthreads();
                if (ph == 10) {
                tr_loop(a.in[11] + (size_t)1024 * 5632, 1024, 5632, a.in[10] + 1024, (bf16_t*)(ws + W_GU_A), 0, 1, scr, gwt, ngwt, lane);
                tr_loop(a.in[12] + (size_t)2816 * 1024, 2816, 1024, nullptr, (bf16_t*)(ws + W_DN_A), 0, 0, scr, gwt, ngwt, lane);
                bf16_t* bte = (bf16_t*)(ws + BTE);
                for (int idx = gtt; idx < 262144; idx += ngtt) { const int g = idx >> 12, p = (idx >> 6) & 63, j = idx & 63; const float dt = __expf(a.in[28][g]);
                    const float are = a.in[22][g * 64 + p], aim = a.in[23][g * 64 + p]; float abr, abi; cpow(are, aim, dt, 1.f, abr, abi);
                    const float nr = abr - 1.f, ni = abi, den = 1.0f / (are * are + aim * aim), fr_ = (nr * are + ni * aim) * den, fi = (ni * are - nr * aim) * den;
                    float pr, pi; cpow(are, aim, dt, (float)(63 - j), pr, pi); const float wr_ = pr * fr_ - pi * fi, wi = pr * fi + pi * fr_;
                    float re[16], im[16];
#pragma unroll
                    for (int c = 0; c < 16; ++c) { const float bre = a.in[24][(g * 64 + p) * 16 + c], bim = a.in[25][(g * 64 + p) * 16 + c]; re[c] = wr_ * bre - wi * bim; im[c] = wr_ * bim + wi * bre; }
                    u32x4 o; bf16_t* d0 = bte + ((size_t)(g * 128 + p) * 1024 + j * 16); bf16_t* d1 = bte + ((size_t)(g * 128 + 64 + p) * 1024 + j * 16);
                    o.x = pk2(re[0], re[1]); o.y = pk2(re[2], re[3]); o.z = pk2(re[4], re[5]); o.w = pk2(re[6], re[7]); *(u32x4*)d0 = o;
                    o.x = pk2(re[8], re[9]); o.y = pk2(re[10], re[11]); o.z = pk2(re[12], re[13]); o.w = pk2(re[14], re[15]); *(u32x4*)(d0 + 8) = o;
                    o.x = pk2(im[0], im[1]); o.y = pk2(im[2], im[3]); o.z = pk2(im[4], im[5]); o.w = pk2(im[6], im[7]); *(u32x4*)d1 = o;
                    o.x = pk2(im[8], im[9]); o.y = pk2(im[10], im[11]); o.z = pk2(im[12], im[13]); o.w = pk2(im[14], im[15]); *(u32x4*)(d1 + 8) = o; }
                } else {
                tr_loop(a.in[38] + (size_t)1024 * 5632, 1024, 5632, a.in[37] + 1024, (bf16_t*)(ws + W_GU_B), 0, 1, scr, gwt, ngwt, lane);
                tr_loop(a.in[39] + (size_t)2816 * 1024, 2816, 1024, nullptr, (bf16_t*)(ws + W_DN_B), 0, 0, scr, gwt, ngwt, lane);
                }
            }
        } break;
        case 15: if (PH_ON(15)) {
            pg8::Gemm g{xb, (const bf16_t*)(ws + W_INO), 1024, 1024, 1024, 136, 4, 1, 0, 0};
            pg8::EpiU E{(bf16_t*)(ws + UPACK), ss, 16}; pg8::gemm_phase(lds, g, E);
            if (fastffn && !SECOND && tailb >= 0) {
                __syncthreads();
                const float* klag = (const float*)(ws + KLAG); bf16_t* bty = (bf16_t*)(ws + BTY);
                for (int r = gwt; r < 65536; r += ngwt) { const int g = r >> 10, n = r & 1023, l = n >> 4, c = n & 15; bf16_t* dst = bty + (size_t)r * UP_LD;
                    u32x4 o0 = {0u, 0u, 0u, 0u}, o1 = {0u, 0u, 0u, 0u};
                    if (lane <= l) { const float* kp_ = klag + ((size_t)(g * 64 + (l - lane)) * 16 + c) * 16; const f32x4 k0 = *(const f32x4*)kp_, k1 = *(const f32x4*)(kp_ + 4), k2 = *(const f32x4*)(kp_ + 8), k3 = *(const f32x4*)(kp_ + 12);
                        o0.x = pk2(k0.x, k0.y); o0.y = pk2(k0.z, k0.w); o0.z = pk2(k1.x, k1.y); o0.w = pk2(k1.z, k1.w); o1.x = pk2(k2.x, k2.y); o1.y = pk2(k2.z, k2.w); o1.z = pk2(k3.x, k3.y); o1.w = pk2(k3.z, k3.w); }
                    if (lane < 16 * ((l >> 4) + 1)) { *(u32x4*)(dst + 128 + lane * 16) = o0; *(u32x4*)(dst + 128 + lane * 16 + 8) = o1; }
                    const float dt = __expf(a.in[28][g]); float pr, pi; cpow(a.in[22][g * 64 + lane], a.in[23][g * 64 + lane], dt, (float)(l + 1), pr, pi);
                    const float cr = a.in[26][(g * 16 + c) * 64 + lane], ci = a.in[27][(g * 16 + c) * 64 + lane];
                    dst[lane] = f2bf(cr * pr - ci * pi); dst[64 + lane] = f2bf(-(cr * pi + ci * pr)); }
            }
        } break;
        case 16: if (PH_ON(16)) {
            pg8::Gemm g{(const bf16_t*)(ws + UPACK) + 128, (const bf16_t*)(ws + BTE), UP_LD, 1024, 1024, 3, 1, 64, (long)NCH * UP_LD, (long)128 * 1024};
            pg8::EpiE E{(float*)(ws + EBUF)}; pg8::gemm_phase(lds, g, E);
        } break;
        case 17: if (PH_ON(17)) {
            const float* eb = (const float*)(ws + EBUF); bf16_t* up = (bf16_t*)(ws + UPACK);
            for (int idx = gt; idx < 48 * 4096; idx += ngt) { const int bg = idx >> 12, g = (idx >> 6) & 63, p = idx & 63; const float dt = __expf(a.in[28][g]);
                float ar, ai; cpow(a.in[22][g * 64 + p], a.in[23][g * 64 + p], dt, 64.f, ar, ai);
                float hr = 0.f, hi = 0.f; int chunk0, n; float* o_re; float* o_im;
                if (bg < 16) { chunk0 = bg * 32; n = 32; o_re = out + O_SREP + (size_t)(bg * 64 + g) * 64 + p; o_im = out + O_SIMP + (size_t)(bg * 64 + g) * 64 + p; }
                else { const int bs = bg - 16; chunk0 = 512 + bs; n = 1; hr = a.in[5][(size_t)(bs * 64 + g) * 64 + p]; hi = a.in[6][(size_t)(bs * 64 + g) * 64 + p]; o_re = out + O_SRES + (size_t)(bs * 64 + g) * 64 + p; o_im = out + O_SIMS + (size_t)(bs * 64 + g) * 64 + p; }
                if (n == 32) {
                    for (int c0 = 0; c0 < 32; c0 += 8) { float er[8], ei[8];
#pragma unroll
                        for (int c = 0; c < 8; ++c) { const size_t r = (size_t)g * NCH + chunk0 + c0 + c; er[c] = eb[r * 128 + p]; ei[c] = eb[r * 128 + 64 + p]; }
#pragma unroll
                        for (int c = 0; c < 8; ++c) { const size_t r = (size_t)g * NCH + chunk0 + c0 + c; up[r * UP_LD + p] = f2bf(hr); up[r * UP_LD + 64 + p] = f2bf(hi);
                            const float nr = ar * hr - ai * hi + er[c], ni = ar * hi + ai * hr + ei[c]; hr = nr; hi = ni; } }
                } else { const size_t r = (size_t)g * NCH + chunk0; up[r * UP_LD + p] = f2bf(hr); up[r * UP_LD + 64 + p] = f2bf(hi);
                    const float er = eb[r * 128 + p], ei = eb[r * 128 + 64 + p]; const float nr = ar * hr - ai * hi + er, ni = ar * hi + ai * hr + ei; hr = nr; hi = ni; }
                *o_re = hr; *o_im = hi; }
        } break;
        case 18: if (PH_ON(18)) {
            pg8::Gemm g{(const bf16_t*)(ws + UPACK), (const bf16_t*)(ws + BTY), UP_LD, UP_LD, UP_LD, 3, 4, 64, (long)NCH * UP_LD, (long)1024 * UP_LD, 1};
            pg8::EpiY E{(bf16_t*)(ws + YBUF), (const bf16_t*)(ws + UPACK), a.in[29]}; pg8::gemm_phase(lds, g, E);
        } break;
        case 19: if (PH_ON(19)) {
            pg8::Gemm g{(const bf16_t*)(ws + YBUF), (const bf16_t*)(ws + W_GLU), 16, 1024, 1024, 136, 8, 1, (long)T * 16, 0, 0, 1};
            pg8::EpiGluResid E{xb, ss, RMUL}; pg8::gemm_phase(lds, g, E);
        } break;
        default: if (PH_ON(25)) {
            const float* gf = a.in[40];
            for (int row0 = gw; row0 < T; row0 += 4 * ngw) {
                u32x2 xw[4][4]; bool ok[4];
#pragma unroll
                for (int q = 0; q < 4; ++q) { const int row = row0 + q * ngw; ok[q] = row < T; const int rr = ok[q] ? row : gw;
#pragma unroll
                    for (int j = 0; j < 4; ++j) xw[q][j] = *(const u32x2*)(xb + (size_t)rr * DM + 4 * lane + 256 * j); }
#pragma unroll
                for (int q = 0; q < 4; ++q) { const int row = row0 + q * ngw; float* p = out + O_Y + (size_t)row * DM; f32x4 v[4]; float s = 0.f;
#pragma unroll
                    for (int j = 0; j < 4; ++j) { const u32x2 w = xw[q][j]; v[j] = (f32x4){bf_lo(w.x), bf_hi(w.x), bf_lo(w.y), bf_hi(w.y)};
                        s += (v[j].x * v[j].x + v[j].y * v[j].y) + (v[j].z * v[j].z + v[j].w * v[j].w); }
                    const float rs = __builtin_amdgcn_rsqf(wave_sum(s) * (1.0f / 1024.0f) + EPS);
                    if (ok[q]) {
#pragma unroll
                        for (int j = 0; j < 4; ++j) { const f32x4 gg = *(const f32x4*)(gf + 4 * lane + 256 * j); *(f32x4*)(p + 4 * lane + 256 * j) = v[j] * rs * gg; } } }
            }
        } break;
        }
    }
}

__global__ void __launch_bounds__(512, 2) mk(Args a) {
    extern __shared__ __attribute__((aligned(16))) unsigned char shm[];
    LAS unsigned char* lds = (LAS unsigned char*)shm;
    const int lo = a.ph_lo, hi = a.ph_hi;
    volatile LAS unsigned* bst = (volatile LAS unsigned*)(lds + LDS_BYTES);
    if (threadIdx.x == 0) { bst[0] = 0u; bst[1] = 0u; bst[2] = 0u; bst[3] = 0u; }
    __syncthreads();
    XcdBarrier xbar; xbar.bar = (unsigned*)(a.ws + WS_BAR); xbar.x = 0; xbar.st = bst;
    if (hi - lo > 1) xbar = xcd_barrier_post((unsigned*)(a.ws + WS_BAR), bst);
    if (lo > 1000) cg::this_grid().sync();
#define STEP(p, k) if (lo <= (p) && (p) < hi) { run_phase<k>(a, lds, xbar); if (((DBLMASK) >> (k)) & 1u) { __syncthreads(); run_phase<k, true>(a, lds, xbar); } } if (lo <= (p) && (p) + 1 < hi) xcd_barrier(xbar);
    STEP(0, 0) STEP(1, 1) STEP(2, 2) STEP(3, 3) STEP(4, 4) STEP(5, 5) STEP(6, 6) STEP(7, 7) STEP(8, 8) STEP(9, 9) STEP(10, 10) STEP(11, 11) STEP(12, 12) STEP(13, 13) STEP(14, 14) STEP(15, 15) STEP(16, 16) STEP(17, 17) STEP(18, 18) STEP(19, 19) STEP(20, 20) STEP(21, 21) STEP(22, 22) STEP(23, 23) STEP(24, 24) STEP(25, 25)
#undef STEP
}


extern "C" void kernel_launch(void* const* d_in, const int* in_sizes, int n_in, void* d_out, int out_size, void* d_ws, size_t ws_size, hipStream_t stream) {
    static int grid = 0;
    if (grid == 0) {
        if (n_in != 41 || (size_t)out_size != O_END || ws_size < WS_END) { fprintf(stderr, "kernel_launch: unexpected shapes: n_in %d out %d ws %zu (need %zu)\n", n_in, out_size, ws_size, (size_t)WS_END); grid = -1; return; }
        int dev = 0, cus = 0, per_cu = 0;
        hipGetDevice(&dev); hipDeviceGetAttribute(&cus, hipDeviceAttributeMultiprocessorCount, dev);
        if (hipFuncSetAttribute((const void*)mk, hipFuncAttributeMaxDynamicSharedMemorySize, LDS_BYTES + 16) != hipSuccess) { fprintf(stderr, "kernel_launch: hipFuncSetAttribute failed\n"); grid = -1; return; }
        if (hipOccupancyMaxActiveBlocksPerMultiprocessor(&per_cu, (const void*)mk, 512, LDS_BYTES + 16) != hipSuccess || per_cu < 1) { fprintf(stderr, "kernel_launch: occupancy query says %d\n", per_cu); per_cu = 1; }
        (void)hipGetLastError();
        grid = cus * per_cu;
        if (grid != 256) { fprintf(stderr, "kernel_launch: this build's phase schedule is laid out for 256 co-resident workgroups (one per CU of a 256-CU device); got %d; nothing launched\n", grid); grid = -1; return; }
    }
    if (grid < 0) return;
    if (hipMemsetAsync((char*)d_ws + WS_BAR, 0, XCD_BAR_BYTES, stream) != hipSuccess) { fprintf(stderr, "kernel_launch: memset of the barrier words failed\n"); return; }
    Args a{};
    for (int i = 0; i < 41; ++i) a.in[i] = (const float*)d_in[i];
    a.out = (float*)d_out; a.ws = (unsigned char*)d_ws;
#if MK_PER_PHASE
    for (int ph = 0; ph < NPHASE; ++ph) { a.ph_lo = ph; a.ph_hi = ph + 1; hipLaunchKernelGGL(mk, dim3(grid), dim3(512), LDS_BYTES + 16, stream, a); }
#else
    a.ph_lo = 0; a.ph_hi = NPHASE;
    void* args[] = {&a};
    hipError_t e = hipLaunchCooperativeKernel((const void*)mk, dim3(grid), dim3(512), args, LDS_BYTES + 16, stream);
    if (e != hipSuccess) fprintf(stderr, "cooperative launch failed: %s (grid %d)\n", hipGetErrorString(e), grid);
#endif
}
```
